# Optimizing an MI355X kernel written in HIP

```python
import jax
import jax.numpy as jnp
from jax import lax
import numpy as np


D_MODEL = 2048
BATCH = 2
SEQ = 4096
DEPTH = 4

N_MIXERS = 4
HEAD_DIM = 128
N_HEADS = D_MODEL // HEAD_DIM
D_FF = 4 * D_MODEL
EPS = 1e-6
NEG = -1e30
BIG = 1e4
CONV_WIDTH = 3
NSA_KV_GROUPS = 4
NSA_HPG = N_HEADS // NSA_KV_GROUPS
CMP_LEN = 32
CMP_STRIDE = 16
SEL_LEN = 64
SEL_TOPK = 16
WINDOW = 512
Q_BLOCK = 128
SEL_Q_CHUNK = 64
POOL_WINDOWS = (2, 4, 8, 16)
POOL_GROUP = D_MODEL // len(POOL_WINDOWS)
NSA_IN_WIDTH = N_HEADS * HEAD_DIM + 6 * NSA_KV_GROUPS * HEAD_DIM + 3 * N_HEADS

kernel_name = 'hybrid_interleaved_conv_nsa_pool_stickbreak'


def rmsnorm(x, g):
    xf = x.astype(jnp.float32)
    y = xf * lax.rsqrt(jnp.mean(xf * xf, axis=-1, keepdims=True) + EPS)
    return (y * g.astype(jnp.float32)).astype(x.dtype)


def short_conv_mixer(h, w_in, conv_w, w_out):
    d = h.shape[-1]
    b_gate, c_gate, v = jnp.split(h @ w_in, 3, axis=-1)
    u = c_gate * v
    y = lax.conv_general_dilated(
        u, conv_w[:, None, :].astype(u.dtype), window_strides=(1,),
        padding=[(CONV_WIDTH - 1, 0)], dimension_numbers=('NWC', 'WIO', 'NWC'),
        feature_group_count=d)
    return (b_gate * y) @ w_out


def _compress(t, pos, w1, w2):
    bsz, seq, g, dh = t.shape
    n_c = (seq - CMP_LEN) // CMP_STRIDE + 1
    r = CMP_LEN // CMP_STRIDE
    chunks = t.reshape(bsz, seq // CMP_STRIDE, CMP_STRIDE, g, dh)
    blocks = jnp.concatenate([chunks[:, j:j + n_c] for j in range(r)], axis=2)
    blocks = blocks + pos[:, None, :].astype(t.dtype)
    flat = jnp.moveaxis(blocks, 3, 2).reshape(bsz, n_c, g, CMP_LEN * dh)
    return jax.nn.silu(flat @ w1) @ w2


def nsa_mixer(h, w_in, q_gain, k_gain, cmp_pos, cmp_w1, cmp_w2, w_out):
    bsz, seq, _ = h.shape
    H, G, hpg, dh = N_HEADS, NSA_KV_GROUPS, NSA_HPG, HEAD_DIM
    dt = h.dtype
    scale = dh ** -0.5
    offs = [int(o) for o in np.cumsum([H * dh] + [G * dh] * 6)]
    q, kc, vc, ks, vs, kw, vw, gates = jnp.split(h @ w_in, offs, axis=-1)
    q = rmsnorm(q.reshape(bsz, seq, G, hpg, dh), q_gain)
    pos_q = jnp.arange(seq)

    kcc = rmsnorm(_compress(kc.reshape(bsz, seq, G, dh), cmp_pos[0], cmp_w1[0], cmp_w2[0]), k_gain[0])
    vcc = _compress(vc.reshape(bsz, seq, G, dh), cmp_pos[1], cmp_w1[1], cmp_w2[1])
    n_c = kcc.shape[1]
    c_end = jnp.arange(n_c) * CMP_STRIDE + CMP_LEN - 1
    c_valid = (c_end[None, :] <= pos_q[:, None])[None, :, None, None, :]
    s_c = jnp.einsum('bqghd,bcgd->bqghc', q, kcc).astype(jnp.float32) * scale
    p_c = jnp.where(c_valid, jax.nn.softmax(jnp.where(c_valid, s_c, NEG), axis=-1), 0.0)
    o_cmp = jnp.einsum('bqghc,bcgd->bqghd', p_c.astype(dt), vcc)

    n_s = seq // SEL_LEN
    ci = np.arange(n_c)[:, None]
    sj = np.arange(n_s)[None, :]
    overlap = ((ci * CMP_STRIDE < (sj + 1) * SEL_LEN) &
               (ci * CMP_STRIDE + CMP_LEN > sj * SEL_LEN)).astype(np.float32)
    imp = jnp.einsum('bqgc,cs->bqgs', p_c.sum(axis=3), jnp.asarray(overlap))
    blk = jnp.arange(n_s)[None, :]
    cur = (pos_q // SEL_LEN)[:, None]
    forced = ((blk == 0) | (blk == cur) | (blk == cur - 1))[:, None, :]
    blk_valid = (blk * SEL_LEN <= pos_q[:, None])[:, None, :]
    imp = jnp.where(forced, BIG, jnp.where(blk_valid, imp, -BIG))
    k_top = min(SEL_TOPK, n_s)
    _, idx = lax.top_k(imp, k_top)

    ks_b = rmsnorm(ks.reshape(bsz, seq, G, dh), k_gain[1]).reshape(bsz, n_s, SEL_LEN, G, dh).transpose(0, 3, 1, 2, 4)
    vs_b = vs.reshape(bsz, n_s, SEL_LEN, G, dh).transpose(0, 3, 1, 2, 4)
    n_q = seq // SEL_Q_CHUNK
    q_ch = q.reshape(bsz, n_q, SEL_Q_CHUNK, G, hpg, dh).swapaxes(0, 1)
    idx_ch = idx.reshape(bsz, n_q, SEL_Q_CHUNK, G, k_top).swapaxes(0, 1)
    pos_ch = pos_q.reshape(n_q, SEL_Q_CHUNK)
    bi = jnp.arange(bsz)[:, None, None, None]
    gi = jnp.arange(G)[None, None, :, None]
    lane = jnp.arange(SEL_LEN)

    def sel_chunk(args):
        qc, ic, pc = args
        kg = ks_b[bi, gi, ic]
        vg = vs_b[bi, gi, ic]
        s = jnp.einsum('bcghd,bcgkld->bcghkl', qc, kg).astype(jnp.float32) * scale
        kpos = ic[..., None] * SEL_LEN + lane
        valid = (kpos <= pc[None, :, None, None, None])[:, :, :, None]
        s = jnp.where(valid, s, NEG)
        sh = s.shape
        p = jax.nn.softmax(s.reshape(sh[:4] + (sh[4] * sh[5],)), axis=-1).reshape(sh)
        return jnp.einsum('bcghkl,bcgkld->bcghd', p.astype(dt), vg)

    o_sel = lax.map(sel_chunk, (q_ch, idx_ch, pos_ch)).swapaxes(0, 1).reshape(bsz, seq, G, hpg, dh)

    nb = seq // Q_BLOCK
    nw = WINDOW // Q_BLOCK
    kwn = rmsnorm(kw.reshape(bsz, seq, G, dh), k_gain[2])
    kp = jnp.pad(kwn, ((0, 0), (WINDOW, 0), (0, 0), (0, 0))).reshape(bsz, nb + nw, Q_BLOCK, G, dh)
    vp = jnp.pad(vw.reshape(bsz, seq, G, dh), ((0, 0), (WINDOW, 0), (0, 0), (0, 0))).reshape(bsz, nb + nw, Q_BLOCK, G, dh)
    k_band = jnp.concatenate([kp[:, j:j + nb] for j in range(nw + 1)], axis=2)
    v_band = jnp.concatenate([vp[:, j:j + nb] for j in range(nw + 1)], axis=2)
    qpos = jnp.arange(nb)[:, None] * Q_BLOCK + jnp.arange(Q_BLOCK)[None, :]
    kpos = jnp.arange(nb)[:, None] * Q_BLOCK - WINDOW + jnp.arange((nw + 1) * Q_BLOCK)[None, :]
    w_valid = ((kpos[:, None, :] <= qpos[:, :, None]) & (qpos[:, :, None] - kpos[:, None, :] < WINDOW)
               & (kpos[:, None, :] >= 0))[None, :, :, None, None, :]
    qb = q.reshape(bsz, nb, Q_BLOCK, G, hpg, dh)
    s_w = jnp.einsum('bnqghd,bnkgd->bnqghk', qb, k_band).astype(jnp.float32) * scale
    p_w = jax.nn.softmax(jnp.where(w_valid, s_w, NEG), axis=-1)
    o_win = jnp.einsum('bnqghk,bnkgd->bnqghd', p_w.astype(dt), v_band).reshape(bsz, seq, G, hpg, dh)

    g = jax.nn.sigmoid(gates.astype(jnp.float32)).astype(dt).reshape(bsz, seq, G, hpg, 3)
    o = g[..., 0:1] * o_cmp + g[..., 1:2] * o_sel + g[..., 2:3] * o_win
    return o.reshape(bsz, seq, H * dh) @ w_out


def pool_mixer(h, w_grp, scale):
    bsz, seq, d = h.shape
    n_g = len(POOL_WINDOWS)
    hg = h.reshape(bsz, seq, n_g, POOL_GROUP).astype(jnp.float32)
    c0 = jnp.concatenate([jnp.zeros((bsz, 1, n_g, POOL_GROUP), jnp.float32), jnp.cumsum(hg, axis=1)], axis=1)
    win = jnp.array(POOL_WINDOWS)[None, :]
    pos = jnp.arange(seq)[:, None]
    lo = jnp.maximum(pos + 1 - win, 0)
    cnt = jnp.minimum(pos + 1, win).astype(jnp.float32)
    lower = c0[:, lo, jnp.arange(n_g)[None, :]]
    pooled = (c0[:, 1:] - lower) / cnt[None, :, :, None] - hg
    y = jnp.einsum('bsgc,gce->bsge', pooled.astype(h.dtype), w_grp).reshape(bsz, seq, d)
    return y * scale


def stick_breaking_mixer(h, w_in, q_gain, k_gain, w_out):
    bsz, seq, _ = h.shape
    H, dh = N_HEADS, HEAD_DIM
    q, k, v = jnp.split(h @ w_in, 3, axis=-1)
    q = rmsnorm(q.reshape(bsz, seq, H, dh), q_gain)
    k = rmsnorm(k.reshape(bsz, seq, H, dh), k_gain)
    v = v.reshape(bsz, seq, H, dh)
    nb = seq // Q_BLOCK
    qb = q.reshape(bsz, nb, Q_BLOCK, H, dh).swapaxes(0, 1)
    kpos = jnp.arange(seq)
    scale = dh ** -0.5

    def block(args):
        qc, i = args
        qpos = i * Q_BLOCK + jnp.arange(Q_BLOCK)
        z = jnp.einsum('bqhd,bkhd->bhqk', qc, k).astype(jnp.float32) * scale
        before = kpos[None, :] < qpos[:, None]
        log_1m = jnp.where(before, jax.nn.log_sigmoid(-z), 0.0)
        tail = lax.cumsum(log_1m, axis=3, reverse=True) - log_1m
        a = jnp.where(before, jnp.exp(jax.nn.log_sigmoid(z) + tail), 0.0)
        return jnp.einsum('bhqk,bkhd->bqhd', a.astype(v.dtype), v)

    o = lax.map(block, (qb, jnp.arange(nb))).swapaxes(0, 1).reshape(bsz, seq, H * dh)
    return o @ w_out


def squared_relu_mlp(h, w1, w2):
    a = jax.nn.relu(h @ w1)
    return (a * a) @ w2


def _n_layers_of(kind):
    return len(range(kind, DEPTH, N_MIXERS))


def setup_inputs(seed: int = 0) -> dict:
    key = jax.random.key(seed)
    ks = iter(jax.random.split(key, 32))
    f32 = jnp.float32
    D, dh, L = D_MODEL, HEAD_DIM, CMP_LEN
    nA, nB, nC, nD = (_n_layers_of(kd) for kd in range(N_MIXERS))

    def nrm(shape, fan_in, mult=1.0):
        return jax.random.normal(next(ks), shape, f32) * (mult * fan_in ** -0.5)

    def gain(shape):
        return 1.0 + 0.05 * jax.random.normal(next(ks), shape, f32)

    return {
        'x': jax.random.normal(next(ks), (BATCH, SEQ, D), f32),
        'mix_norm': gain((DEPTH, D)),
        'mlp_norm': gain((DEPTH, D)),
        'mlp_w1': nrm((DEPTH, D, D_FF), D),
        'mlp_w2': nrm((DEPTH, D_FF, D), D_FF),
        'conv_w_in': nrm((nA, D, 3 * D), D),
        'conv_w': nrm((nA, CONV_WIDTH, D), CONV_WIDTH),
        'conv_w_out': nrm((nA, D, D), D),
        'nsa_w_in': nrm((nB, D, NSA_IN_WIDTH), D),
        'nsa_q_gain': gain((nB, dh)),
        'nsa_k_gain': gain((nB, 3, dh)),
        'nsa_cmp_pos': 0.5 * jax.random.normal(next(ks), (nB, 2, L, dh), f32),
        'nsa_cmp_w1': nrm((nB, 2, L * dh, dh), L * dh),
        'nsa_cmp_w2': nrm((nB, 2, dh, dh), dh),
        'nsa_w_out': nrm((nB, N_HEADS * dh, D), N_HEADS * dh),
        'pool_w': nrm((nC, len(POOL_WINDOWS), POOL_GROUP, POOL_GROUP), POOL_GROUP),
        'pool_scale': gain((nC, D)),
        'sb_w_in': nrm((nD, D, 3 * N_HEADS * dh), D),
        'sb_q_gain': gain((nD, dh)),
        'sb_k_gain': gain((nD, dh)),
        'sb_w_out': nrm((nD, N_HEADS * dh, D), N_HEADS * dh),
    }


def reference(x, mix_norm, mlp_norm, mlp_w1, mlp_w2, conv_w_in, conv_w, conv_w_out,
              nsa_w_in, nsa_q_gain, nsa_k_gain, nsa_cmp_pos, nsa_cmp_w1, nsa_cmp_w2, nsa_w_out,
              pool_w, pool_scale, sb_w_in, sb_q_gain, sb_k_gain, sb_w_out):
    for i in range(DEPTH):
        kind, j = i % N_MIXERS, i // N_MIXERS
        h = rmsnorm(x, mix_norm[i])
        if kind == 0:
            y = short_conv_mixer(h, conv_w_in[j], conv_w[j], conv_w_out[j])
        elif kind == 1:
            y = nsa_mixer(h, nsa_w_in[j], nsa_q_gain[j], nsa_k_gain[j], nsa_cmp_pos[j],
                          nsa_cmp_w1[j], nsa_cmp_w2[j], nsa_w_out[j])
        elif kind == 2:
            y = pool_mixer(h, pool_w[j], pool_scale[j])
        else:
            y = stick_breaking_mixer(h, sb_w_in[j], sb_q_gain[j], sb_k_gain[j], sb_w_out[j])
        x = x + y
        x = x + squared_relu_mlp(rmsnorm(x, mlp_norm[i]), mlp_w1[i], mlp_w2[i])
    return x
```

```cpp
#include <hip/hip_runtime.h>
#include <hip/hip_cooperative_groups.h>
#include <cstdio>
#include <cstdint>
namespace cg = cooperative_groups;

#ifndef MK_MULTI
#define MK_MULTI 0
#endif

#ifndef DUPMASK
#define DUPMASK 0ull
#endif
#ifndef TEST_PH
#define TEST_PH -1
#endif
#define PH_EN(n) (TEST_PH < 0 || TEST_PH == (n))
#define LAS __attribute__((address_space(3)))
typedef unsigned short bf16;
typedef short bf16x8 __attribute__((ext_vector_type(8)));
typedef float f32x4 __attribute__((ext_vector_type(4)));
typedef float f32x16 __attribute__((ext_vector_type(16)));
typedef unsigned u32x4 __attribute__((ext_vector_type(4)));
typedef unsigned u32x2 __attribute__((ext_vector_type(2)));

constexpr int BATCH = 2, SEQ = 4096, D = 2048, M = BATCH * SEQ, FF = 8192, NH = 16, HD = 128;
constexpr int NSA_W = 5168, NSA_WP = 5376;
constexpr float EPS = 1e-6f;
constexpr float NEGF = -1e30f;
constexpr float QSCALE = 0.08838834764831845f * 1.4426950408889634f;

constexpr size_t MiB = 1u << 20;
constexpr size_t OFF_SSQ = 1024ull * 1024 * 738;
constexpr size_t OFF_CTL = 0;
constexpr size_t OFF_BIAS1 = 512 * 1024, OFF_BIAS1P = 512 * 1024 + 4096;
constexpr size_t OFF_W1T = 1 * MiB;
constexpr size_t OFF_W2T = OFF_W1T + 128 * MiB;
constexpr size_t OFF_CIN = OFF_W2T + 128 * MiB;
constexpr size_t OFF_COUT = OFF_CIN + 24 * MiB;
constexpr size_t OFF_NIN = OFF_COUT + 8 * MiB;
constexpr size_t OFF_NOUT = OFF_NIN + 21 * MiB;
constexpr size_t OFF_POOL = OFF_NOUT + 8 * MiB;
constexpr size_t OFF_SIN = OFF_POOL + 2 * MiB;
constexpr size_t OFF_SOUT = OFF_SIN + 24 * MiB;
constexpr size_t OFF_WC1 = OFF_SOUT + 8 * MiB;
constexpr size_t OFF_XB = OFF_WC1 + 2 * MiB;
constexpr size_t OFF_H = OFF_XB + 32 * MiB;
constexpr size_t OFF_RAW = OFF_H + 128 * MiB;
constexpr size_t OFF_Z = OFF_RAW + 96 * MiB;
constexpr size_t OFF_QN = OFF_Z + 32 * MiB;
constexpr size_t OFF_KF = OFF_QN + 32 * MiB;
constexpr size_t OFF_VF = OFF_KF + 32 * MiB;
constexpr size_t WS_END = OFF_VF + 32 * MiB + 16 * MiB;
static_assert(OFF_SSQ == OFF_VF + 32 * MiB, "ssq partials sit after VF");
constexpr int SSQ_STRIDE = M * 32;
constexpr size_t OFF_KFS = OFF_KF, OFF_KFW = OFF_KF + 8 * MiB, OFF_KCG = OFF_KF + 16 * MiB, OFF_VCG = OFF_KF + 24 * MiB;
constexpr size_t OFF_VFS = OFF_VF, OFF_VFW = OFF_VF + 8 * MiB, OFF_Y = OFF_KF + 16 * MiB  , OFF_KFC = OFF_VF + 20 * MiB, OFF_VFC = OFF_VF + 21 * MiB, OFF_GATE = OFF_VF + 22 * MiB;

constexpr int NWAVES = 8, NTHREADS = 512;
constexpr int LDS_BYTES = 147456;
constexpr int NPH = 26;

namespace pg8 {
constexpr int BM = 256, BK = 64, HALF = 128, HTB = HALF * BK * 2, STAGE_BYTES = 8 * HTB, NXCD = 8, WGM = 4;
__device__ __forceinline__ int lds_byte(int r, int c) { const int st = (r >> 4) * 2 + (c >> 5), rr = r & 15, cc = c & 31, ob = rr * 64 + cc * 2; return st * 1024 + (ob ^ (((ob >> 9) & 1) << 5)); }
__device__ __forceinline__ void stage_rc(int b, int& R, int& C) { const int st = b / 1024, sb = b % 1024, swz = sb ^ (((sb >> 9) & 1) << 5); R = (st >> 1) * 16 + swz / 64; C = (st & 1) * 32 + (swz % 64) / 2; }
__device__ __forceinline__ int perm32(int rho) { const int n = rho >> 4, i = rho & 15; return 8 * (i >> 2) + 4 * n + (i & 3); }
struct Unit { int pm, pn; };
struct Gemm { const bf16* A; const bf16* Bt; int M, N, K, lda, ldb, agrp; };
struct StaticOrder {
    int nM, nN, nwg, G, c;
    __device__ void init(int M_, int N_, int G_, int c_) { nM = M_ / BM; nN = N_ / BM; nwg = nM * nN; G = G_; c = c_; }
    __device__ bool next(int i, Unit& u) const {
        const long L = (long)i * G + c; if (L >= nwg) return false;
        int wgid = (int)L; { const int q = nwg / NXCD, r = nwg % NXCD, xcd = wgid % NXCD, off = wgid / NXCD; wgid = (xcd < r ? xcd * (q + 1) : r * (q + 1) + (xcd - r) * q) + off; }
        const int nig = WGM * nM, gid = wgid / nig, fn = gid * WGM, gsz = (nN - fn) < WGM ? (nN - fn) : WGM;
        u.pn = fn + ((wgid % nig) % gsz); u.pm = (wgid % nig) / gsz; return true;
    }
};
__device__ __forceinline__ unsigned cvt_pk_bf16(float lo, float hi) { unsigned r; asm volatile("v_cvt_pk_bf16_f32 %0, %1, %2" : "=v"(r) : "v"(lo), "v"(hi)); return r; }

struct Epi {
    int mode; bf16* O; int ldc; const float* ssq_in; const float* xin; float* xout; float* ssq_out;
    __device__ __forceinline__ void operator()(const f32x4 (&acc)[2][2][4][2], const Unit& u, int wr, int wc, int fr, int fq, int ui, const LAS float* rsl) const {
        const int row0 = u.pm * BM + wr * 64 + fr, col0 = u.pn * BM + wc * 32 + 8 * fq;
        if (mode != 2) {
#pragma unroll
            for (int ai = 0; ai < 2; ++ai)
#pragma unroll
                for (int m = 0; m < 4; ++m) {
                    const int row = row0 + ai * HALF + m * 16;
                    float rs = 1.0f;
                    if (ssq_in && ui < 4) rs = rsl[ui * 256 + ai * HALF + wr * 64 + m * 16 + fr];
                    else if (ssq_in) { const f32x4* pp = (const f32x4*)(ssq_in + (size_t)row * 32); f32x4 s4 = pp[0];
#pragma unroll
                        for (int j = 1; j < 8; ++j) s4 += pp[j];
                        rs = __builtin_amdgcn_rsqf(((s4.x + s4.y) + (s4.z + s4.w)) * (1.0f / D) + EPS); }
                    bf16* rowp = O + (size_t)row * ldc + col0;
#pragma unroll
                    for (int bj = 0; bj < 2; ++bj) {
                        f32x4 v0 = acc[ai][bj][m][0] * rs, v1 = acc[ai][bj][m][1] * rs;
                        if (mode == 1) {
#pragma unroll
                            for (int e = 0; e < 4; ++e) { float a = fmaxf(v0[e], 0.f), b = fmaxf(v1[e], 0.f); v0[e] = a * a; v1[e] = b * b; }
                        }
                        u32x4 w; w.x = cvt_pk_bf16(v0[0], v0[1]); w.y = cvt_pk_bf16(v0[2], v0[3]); w.z = cvt_pk_bf16(v1[0], v1[1]); w.w = cvt_pk_bf16(v1[2], v1[3]);
                        *(u32x4*)(rowp + bj * HALF) = w;
                    }
                }
        } else {
            u32x4 rb[16];
#pragma unroll
            for (int ai = 0; ai < 2; ++ai)
#pragma unroll
                for (int m = 0; m < 4; ++m)
#pragma unroll
                    for (int bj = 0; bj < 2; ++bj) rb[(ai * 4 + m) * 2 + bj] = *(const u32x4*)(O + (size_t)(row0 + ai * HALF + m * 16) * D + col0 + bj * HALF);
            asm volatile("" : "+v"(rb[0]), "+v"(rb[1]), "+v"(rb[2]), "+v"(rb[3]), "+v"(rb[4]), "+v"(rb[5]), "+v"(rb[6]), "+v"(rb[7]));
            asm volatile("" : "+v"(rb[8]), "+v"(rb[9]), "+v"(rb[10]), "+v"(rb[11]), "+v"(rb[12]), "+v"(rb[13]), "+v"(rb[14]), "+v"(rb[15]));
#pragma unroll
            for (int ai = 0; ai < 2; ++ai)
#pragma unroll
                for (int m = 0; m < 4; ++m) {
                    const int row = row0 + ai * HALF + m * 16;
                    float s = 0.f;
#pragma unroll
                    for (int bj = 0; bj < 2; ++bj) {
                        const size_t p = (size_t)row * D + col0 + bj * HALF;
                        const u32x4 rbv = rb[(ai * 4 + m) * 2 + bj];
                        const f32x4 r0 = {__builtin_bit_cast(float, rbv.x << 16), __builtin_bit_cast(float, rbv.x & 0xffff0000u), __builtin_bit_cast(float, rbv.y << 16), __builtin_bit_cast(float, rbv.y & 0xffff0000u)};
                        const f32x4 r1 = {__builtin_bit_cast(float, rbv.z << 16), __builtin_bit_cast(float, rbv.z & 0xffff0000u), __builtin_bit_cast(float, rbv.w << 16), __builtin_bit_cast(float, rbv.w & 0xffff0000u)};
                        const f32x4 v0 = acc[ai][bj][m][0] + r0, v1 = acc[ai][bj][m][1] + r1;
                        if (xout) { *(f32x4*)(xout + p) = v0; *(f32x4*)(xout + p + 4) = v1; }
                        u32x4 w; w.x = cvt_pk_bf16(v0[0], v0[1]); w.y = cvt_pk_bf16(v0[2], v0[3]); w.z = cvt_pk_bf16(v1[0], v1[1]); w.w = cvt_pk_bf16(v1[2], v1[3]);
                        *(u32x4*)(O + p) = w;
                        s += (v0[0] * v0[0] + v0[1] * v0[1]) + (v0[2] * v0[2] + v0[3] * v0[3]) + (v1[0] * v1[0] + v1[1] * v1[1]) + (v1[2] * v1[2] + v1[3] * v1[3]);
                    }
                    s += __shfl_xor(s, 16); s += __shfl_xor(s, 32);
                    if (fq == 0) ssq_out[(size_t)row * 32 + (u.pn & 7) * 4 + wc] = s;
                }
        }
    }
};

template <bool ALIGN_EPI>
__device__ __forceinline__ void gemm_phase(LAS unsigned char* lds, const Gemm g, const StaticOrder& S, const Epi& E, const int tid) {
    const int wid = __builtin_amdgcn_readfirstlane(tid >> 6), lane = tid & 63, wr = wid >> 2, wc = wid & 3, fr = lane & 15, fq = lane >> 4;
    const int K = g.K, nt = K / BK;
    unsigned voffA[2], voffB[2];
#pragma unroll
    for (int i = 0; i < 2; ++i) { int R, C; stage_rc(tid * 16 + i * 8192, R, C); const int Rb = (R & ~31) + perm32(R & 31);
        voffA[i] = (unsigned)(R * g.lda + C) * 2u; voffB[i] = (unsigned)(Rb * g.ldb + C) * 2u; }
    LAS float* rsl = (LAS float*)(lds + STAGE_BYTES);
    const size_t kstep = (size_t)(BK * 2);
    const size_t hstepA = (size_t)HALF * g.lda * 2, hstepB = (size_t)HALF * g.ldb * 2;
    const unsigned ldsw = (unsigned)wid * 1024u;
    const int aoff = lds_byte(wr * 64 + fr, fq * 8), boff = lds_byte(wc * 32 + fr, fq * 8);
#define PG8_SA(b, h) (((b) * 2 + (h)) * HTB)
#define PG8_SB(b, h) ((4 + (b) * 2 + (h)) * HTB)
#define PG8_STAGE(bufoff, gbase, voff) do { _Pragma("unroll") for (int _i = 0; _i < 2; ++_i) \
        __builtin_amdgcn_global_load_lds((const unsigned*)((const char*)(gbase) + (voff)[_i]), (LAS unsigned*)(lds + (bufoff) + ldsw + _i * 8192), 16, 0, 0); } while (0)
#define PG8_LDA(dst, b, h) do { _Pragma("unroll") for (int m = 0; m < 4; ++m) _Pragma("unroll") for (int k = 0; k < 2; ++k) dst[m][k] = *(const LAS bf16x8*)(lds + PG8_SA(b, h) + aoff + m * 2048 + k * 1024); } while (0)
#define PG8_LDB(dst, b, h) do { _Pragma("unroll") for (int n = 0; n < 2; ++n) _Pragma("unroll") for (int k = 0; k < 2; ++k) dst[n][k] = *(const LAS bf16x8*)(lds + PG8_SB(b, h) + boff + n * 2048 + k * 1024); } while (0)
#define PG8_MMA(ai, bj, At, Bt) do { __builtin_amdgcn_s_setprio(1); _Pragma("unroll") for (int m = 0; m < 4; ++m) _Pragma("unroll") for (int n = 0; n < 2; ++n) _Pragma("unroll") for (int k = 0; k < 2; ++k) \
        acc[ai][bj][m][n] = __builtin_amdgcn_mfma_f32_16x16x32_bf16(Bt[n][k], At[m][k], acc[ai][bj][m][n], 0, 0, 0); __builtin_amdgcn_s_setprio(0); } while (0)
#define PG8_WAIT_V(n) asm volatile("s_waitcnt vmcnt(" #n ")" ::: "memory")
#define PG8_WAIT_L(n) asm volatile("s_waitcnt lgkmcnt(" #n ")" ::: "memory")
#define PG8_BAR __builtin_amdgcn_s_barrier()
#define PG8_SCHED __builtin_amdgcn_sched_barrier(0)
    Unit cur, nxt; int ui = 0;
    if (!S.next(0, cur)) return;
    f32x4 acc[2][2][4][2];
#pragma unroll
    for (int a = 0; a < 2; ++a)
#pragma unroll
        for (int b = 0; b < 2; ++b)
#pragma unroll
            for (int m = 0; m < 4; ++m)
#pragma unroll
                for (int n = 0; n < 2; ++n) acc[a][b][m][n] = (f32x4){0.f, 0.f, 0.f, 0.f};
    bf16x8 At[4][2], B0[2][2], B1[2][2];
    const char* cA = (const char*)g.A + (size_t)cur.pm * 2 * hstepA + (g.agrp ? (size_t)(cur.pn >> 1) * 1024 : 0);
    const char* cB = (const char*)g.Bt + (size_t)cur.pn * 2 * hstepB;
    PG8_STAGE(PG8_SB(0, 0), cB, voffB); PG8_STAGE(PG8_SB(0, 1), cB + hstepB, voffB); PG8_STAGE(PG8_SA(0, 0), cA, voffA); PG8_STAGE(PG8_SA(0, 1), cA + hstepA, voffA);
    if (E.mode != 2 && E.ssq_in) {
        for (int i = tid; i < 4 * 256; i += 512) { Unit uu;
            if (S.next(i >> 8, uu)) { const f32x4* pp = (const f32x4*)(E.ssq_in + (size_t)(uu.pm * BM + (i & 255)) * 32); f32x4 s4 = pp[0];
#pragma unroll
                for (int j = 1; j < 8; ++j) s4 += pp[j];
                rsl[i] = __builtin_amdgcn_rsqf(((s4.x + s4.y) + (s4.z + s4.w)) * (1.0f / D) + EPS); } }
    }
    if (wr == 1) PG8_BAR;
    PG8_WAIT_V(2); PG8_BAR;
    PG8_STAGE(PG8_SB(1, 0), cB + kstep, voffB); PG8_STAGE(PG8_SA(1, 0), cA + kstep, voffA); PG8_STAGE(PG8_SB(1, 1), cB + hstepB + kstep, voffB);
    PG8_WAIT_V(6); PG8_BAR;
    for (;;) {
        const bool has_next = S.next(ui + 1, nxt);
        const char* nA = has_next ? (const char*)g.A + (size_t)nxt.pm * 2 * hstepA + (g.agrp ? (size_t)(nxt.pn >> 1) * 1024 : 0) : cA;
        const char* nB = has_next ? (const char*)g.Bt + (size_t)nxt.pn * 2 * hstepB : cB;
        for (int t = 0; t < nt; t += 2) {
            const bool last = (t == nt - 2);
            const char* a1 = cA + (size_t)(t + 1) * kstep;
            const char* a2 = last ? nA : cA + (size_t)(t + 2) * kstep; const char* b2 = last ? nB : cB + (size_t)(t + 2) * kstep;
            const char* a3 = a2 + kstep; const char* b3 = b2 + kstep;
            PG8_LDB(B0, 0, 0); PG8_LDB(B1, 0, 1); PG8_SCHED; PG8_LDA(At, 0, 0); PG8_STAGE(PG8_SA(1, 1), a1 + hstepA, voffA);
            PG8_WAIT_V(8); PG8_WAIT_L(0); PG8_BAR; PG8_MMA(0, 0, At, B0); PG8_MMA(0, 1, At, B1); PG8_BAR; PG8_SCHED;
            PG8_LDA(At, 0, 1); PG8_STAGE(PG8_SB(0, 0), b2, voffB); PG8_STAGE(PG8_SB(0, 1), b2 + hstepB, voffB); PG8_STAGE(PG8_SA(0, 0), a2, voffA);
            PG8_WAIT_V(8); PG8_WAIT_L(0); PG8_BAR; PG8_MMA(1, 0, At, B0); PG8_MMA(1, 1, At, B1); PG8_BAR; PG8_SCHED;
            PG8_LDB(B0, 1, 0); PG8_LDB(B1, 1, 1); PG8_SCHED; PG8_LDA(At, 1, 0); PG8_STAGE(PG8_SA(0, 1), a2 + hstepA, voffA);
            PG8_WAIT_V(8); PG8_WAIT_L(0); PG8_BAR; PG8_MMA(0, 0, At, B0); PG8_MMA(0, 1, At, B1); PG8_BAR; PG8_SCHED;
            PG8_LDA(At, 1, 1); PG8_STAGE(PG8_SB(1, 0), b3, voffB); PG8_STAGE(PG8_SB(1, 1), b3 + hstepB, voffB); PG8_STAGE(PG8_SA(1, 0), a3, voffA);
            PG8_WAIT_V(8); PG8_WAIT_L(0); PG8_BAR; PG8_MMA(1, 0, At, B0); PG8_MMA(1, 1, At, B1); PG8_BAR; PG8_SCHED;
        }
        if constexpr (ALIGN_EPI) { if (wr == 0) PG8_BAR; }
        E(acc, cur, wr, wc, fr, fq, ui, rsl);
        if (!has_next) break;
#pragma unroll
        for (int a = 0; a < 2; ++a)
#pragma unroll
            for (int b = 0; b < 2; ++b)
#pragma unroll
                for (int m = 0; m < 4; ++m)
#pragma unroll
                    for (int n = 0; n < 2; ++n) acc[a][b][m][n] = (f32x4){0.f, 0.f, 0.f, 0.f};
        cur = nxt; cA = nA; cB = nB; ++ui;
        if constexpr (ALIGN_EPI) { if (wr == 1) PG8_BAR; }
    }
    PG8_WAIT_V(0);
    if constexpr (!ALIGN_EPI) { if (wr == 0) PG8_BAR; }
    PG8_BAR;
#undef PG8_SA
#undef PG8_SB
#undef PG8_STAGE
#undef PG8_LDA
#undef PG8_LDB
#undef PG8_MMA
#undef PG8_WAIT_V
#undef PG8_WAIT_L
#undef PG8_BAR
#undef PG8_SCHED
}
}

#define LDS_WAIT() asm volatile("s_waitcnt lgkmcnt(0)" ::: "memory")
__device__ __forceinline__ unsigned f2bf(float f) { unsigned u = __builtin_bit_cast(unsigned, f); return (u + 0x7fffu + ((u >> 16) & 1u)) >> 16; }
typedef float f32x2_t __attribute__((ext_vector_type(2))); typedef __bf16 bf16x2_t __attribute__((ext_vector_type(2)));
__device__ __forceinline__ unsigned pk2(float lo, float hi) { f32x2_t v = {lo, hi}; bf16x2_t b = __builtin_convertvector(v, bf16x2_t); return __builtin_bit_cast(unsigned, b); }
__device__ __forceinline__ float bflo(unsigned w) { return __builtin_bit_cast(float, w << 16); }
__device__ __forceinline__ float bfhi(unsigned w) { return __builtin_bit_cast(float, w & 0xffff0000u); }
__device__ __forceinline__ float bf1(bf16 h) { return __builtin_bit_cast(float, (unsigned)h << 16); }
__device__ __forceinline__ void unpack8(const u32x4 v, float (&f)[8]) { f[0] = bflo(v.x); f[1] = bfhi(v.x); f[2] = bflo(v.y); f[3] = bfhi(v.y); f[4] = bflo(v.z); f[5] = bfhi(v.z); f[6] = bflo(v.w); f[7] = bfhi(v.w); }
__device__ __forceinline__ u32x4 pack8f(const float (&f)[8]) { u32x4 w; w.x = pk2(f[0], f[1]); w.y = pk2(f[2], f[3]); w.z = pk2(f[4], f[5]); w.w = pk2(f[6], f[7]); return w; }
__device__ __forceinline__ float wave_sum(float v) {
#pragma unroll
    for (int o = 1; o < 64; o <<= 1) v += __shfl_xor(v, o);
    return v;
}
__device__ __forceinline__ unsigned cvtpk(float lo, float hi) { f32x2_t v = {lo, hi}; bf16x2_t b = __builtin_convertvector(v, bf16x2_t); return __builtin_bit_cast(unsigned, b); }
#define PIN8(a) asm volatile("" : "+v"(a[0]), "+v"(a[1]), "+v"(a[2]), "+v"(a[3]), "+v"(a[4]), "+v"(a[5]), "+v"(a[6]), "+v"(a[7]))
#define MFMA32(a, b, c) __builtin_amdgcn_mfma_f32_32x32x16_bf16((a), (b), (c), 0, 0, 0)
__device__ __forceinline__ int crow(int r, int hi) { return (r & 3) + 8 * (r >> 2) + 4 * hi; }
__device__ __forceinline__ float ex2(float x) { return __builtin_amdgcn_exp2f(x); }

constexpr int TR_SCR = 64 * 65 * 4;
__device__ __forceinline__ void tr_item(const float* W, int K, int N, bf16* WT, int ldw, int row_off, const float* ksc, const float* nsc, LAS float* scr, int item, int lane) {
    const int nblk = (N + 63) / 64;
    int kb, nb;
    if ((nblk & 1) == 0) { const int q = item >> 3, w = item & 7, nq = nblk >> 1; nb = (q % nq) * 2 + (w & 1); kb = (q / nq) * 4 + (w >> 1); }
    else { kb = item / nblk; nb = item % nblk; }
    const int k0 = 64 * kb, n0 = 64 * nb;
    const int nn = n0 + 4 * (lane & 15), kr = lane >> 4; const bool nok = nn < N;
    f32x4 ns = {1.f, 1.f, 1.f, 1.f};
    if (nsc && nok) ns = *(const f32x4*)(nsc + nn);
    f32x4 v[16];
#pragma unroll
    for (int i = 0; i < 16; ++i) v[i] = nok ? *(const f32x4*)(W + (size_t)(k0 + 4 * i + kr) * N + nn) : (f32x4){0.f, 0.f, 0.f, 0.f};
#pragma unroll
    for (int i = 0; i < 16; ++i) { const int kk = 4 * i + kr; f32x4 x = v[i] * ns; if (ksc) x = x * ksc[k0 + kk];
        LAS float* d = scr + kk * 65 + 4 * (lane & 15); d[0] = x.x; d[1] = x.y; d[2] = x.z; d[3] = x.w; }
    LDS_WAIT(); asm volatile("" ::: "memory");
    const int c = lane & 7;
#pragma unroll
    for (int j = 0; j < 8; ++j) { const int n = (lane >> 3) + 8 * j; const LAS float* sp = scr + (8 * c) * 65 + n;
        u32x4 o; o.x = pk2(sp[0 * 65], sp[1 * 65]); o.y = pk2(sp[2 * 65], sp[3 * 65]); o.z = pk2(sp[4 * 65], sp[5 * 65]); o.w = pk2(sp[6 * 65], sp[7 * 65]);
        if (n0 + n < N) *(u32x4*)(WT + (size_t)(row_off + n0 + n) * ldw + k0 + 8 * c) = o; }
    LDS_WAIT(); asm volatile("" ::: "memory");
}

struct Args { const float* in[21]; float* out; unsigned char* ws; int ph_lo, ph_hi; };

__device__ __forceinline__ void prologue(const Args& a, LAS unsigned char* lds, int wave, int lane, int G, int bid) {
    LAS float* scr = (LAS float*)(lds + wave * TR_SCR);
    const int gw = bid * NWAVES + wave, NGW = G * NWAVES;
    unsigned char* ws = a.ws;
    const float* mixn = a.in[1]; const float* mlpn = a.in[2];
    constexpr int I_W1 = (D / 64) * (FF / 64), I_W2 = (FF / 64) * (D / 64), I_IN = (D / 64) * (6144 / 64), I_SQ = (D / 64) * (D / 64),
                  I_NIN = (D / 64) * ((NSA_W + 63) / 64), I_POOL = (512 / 64) * (512 / 64), I_C1 = (2048 / 64) * (128 / 64);
    constexpr int NITEMS = 4 * I_W1 + 4 * I_W2 + 2 * I_IN + 3 * I_SQ + I_NIN + 4 * I_POOL + 4 * I_C1;
    for (int it = gw; it < NITEMS; it += NGW) {
        int r = it;
        if (r < 4 * I_W1) { const int l = r / I_W1; tr_item(a.in[3] + (size_t)l * D * FF, D, FF, (bf16*)(ws + OFF_W1T) + (size_t)l * D * FF, D, 0, mlpn + l * D, nullptr, scr, r % I_W1, lane); continue; } r -= 4 * I_W1;
        if (r < 4 * I_W2) { const int l = r / I_W2; tr_item(a.in[4] + (size_t)l * D * FF, FF, D, (bf16*)(ws + OFF_W2T) + (size_t)l * D * FF, FF, 0, nullptr, nullptr, scr, r % I_W2, lane); continue; } r -= 4 * I_W2;
        if (r < I_IN) { tr_item(a.in[5], D, 6144, (bf16*)(ws + OFF_CIN), D, 0, mixn + 0 * D, nullptr, scr, r, lane); continue; } r -= I_IN;
        if (r < I_IN) { tr_item(a.in[17], D, 6144, (bf16*)(ws + OFF_SIN), D, 0, mixn + 3 * D, nullptr, scr, r, lane); continue; } r -= I_IN;
        if (r < I_SQ) { tr_item(a.in[7], D, D, (bf16*)(ws + OFF_COUT), D, 0, nullptr, nullptr, scr, r, lane); continue; } r -= I_SQ;
        if (r < I_SQ) { tr_item(a.in[14], D, D, (bf16*)(ws + OFF_NOUT), D, 0, nullptr, nullptr, scr, r, lane); continue; } r -= I_SQ;
        if (r < I_SQ) { tr_item(a.in[20], D, D, (bf16*)(ws + OFF_SOUT), D, 0, nullptr, nullptr, scr, r, lane); continue; } r -= I_SQ;
        if (r < I_NIN) { tr_item(a.in[8], D, NSA_W, (bf16*)(ws + OFF_NIN), D, 0, mixn + 1 * D, nullptr, scr, r, lane); continue; } r -= I_NIN;
        if (r < 4 * I_POOL) { const int gq = r / I_POOL; tr_item(a.in[15] + (size_t)gq * 512 * 512, 512, 512, (bf16*)(ws + OFF_POOL), 512, gq * 512, nullptr, a.in[16] + gq * 512, scr, r % I_POOL, lane); continue; } r -= 4 * I_POOL;
        { const int q = r / I_C1, which = q >> 1, half = q & 1;
          tr_item(a.in[12] + (size_t)which * 4096 * 128 + (size_t)half * 2048 * 128, 2048, 128, (bf16*)(ws + OFF_WC1) + (size_t)which * 256 * 2048, 2048, half * 128, nullptr, nullptr, scr, r % I_C1, lane); }
    }
    {
        const float* x = a.in[0]; bf16* xb = (bf16*)(ws + OFF_XB); float* ssq = (float*)(ws + OFF_SSQ);
        for (int m = gw; m < M; m += NGW) {
            const f32x4* xr = (const f32x4*)(x + (size_t)m * D) + lane; f32x4 v[8]; float s = 0.f;
#pragma unroll
            for (int j = 0; j < 8; ++j) { v[j] = xr[64 * j]; s += (v[j].x * v[j].x + v[j].y * v[j].y) + (v[j].z * v[j].z + v[j].w * v[j].w); }
            s = wave_sum(s);
            if (lane < 32) ssq[(size_t)m * 32 + lane] = lane == 0 ? s : 0.f;
            u32x2* o8 = (u32x2*)(xb + (size_t)m * D) + lane;
#pragma unroll
            for (int j = 0; j < 8; ++j) { u32x2 w; w.x = pk2(v[j].x, v[j].y); w.y = pk2(v[j].z, v[j].w); o8[64 * j] = w; }
        }
    }
    {
        u32x4* p = (u32x4*)((bf16*)(ws + OFF_NIN) + (size_t)NSA_W * D); const int n16 = (NSA_WP - NSA_W) * D * 2 / 16;
        for (int i = gw * 64 + lane; i < n16; i += NGW * 64) p[i] = (u32x4){0u, 0u, 0u, 0u};
    }
    {
        float* part = (float*)(ws + OFF_BIAS1P);
        for (int t = gw; t < 256; t += NGW) {
            const int which = t >> 7, kc = (t >> 1) & 63, n = (t & 1) * 64 + lane;
            const float* pos = a.in[11] + (size_t)which * 4096 + kc * 64; const float* w1 = a.in[12] + (size_t)which * 4096 * 128 + (size_t)kc * 64 * 128 + n;
            float s = 0.f;
#pragma unroll 16
            for (int i = 0; i < 64; ++i) s += pos[i] * w1[i * 128];
            part[(which * 64 + kc) * 128 + n] = s;
        }
    }
}

__device__ __forceinline__ void conv_phase(const bf16* bcv, const float* cw, bf16* z, int G, int tid, int bid) {
    const int half = tid >> 8, c8 = (tid & 255) * 8;
    float w0[8], w1[8], w2[8];
#pragma unroll
    for (int e = 0; e < 8; ++e) { w0[e] = cw[c8 + e]; w1[e] = cw[D + c8 + e]; w2[e] = cw[2 * D + c8 + e]; }
    for (int it = bid; it < M / 16; it += G) {
        const int t0 = it * 16 + half * 8;
        float um2[8], um1[8];
#pragma unroll
        for (int e = 0; e < 8; ++e) { um2[e] = 0.f; um1[e] = 0.f; }
        if ((t0 & (SEQ - 1)) >= 2) {
            float c[8], v[8];
            unpack8(*(const u32x4*)(bcv + (size_t)(t0 - 2) * 6144 + 2048 + c8), c); unpack8(*(const u32x4*)(bcv + (size_t)(t0 - 2) * 6144 + 4096 + c8), v);
#pragma unroll
            for (int e = 0; e < 8; ++e) um2[e] = c[e] * v[e];
            unpack8(*(const u32x4*)(bcv + (size_t)(t0 - 1) * 6144 + 2048 + c8), c); unpack8(*(const u32x4*)(bcv + (size_t)(t0 - 1) * 6144 + 4096 + c8), v);
#pragma unroll
            for (int e = 0; e < 8; ++e) um1[e] = c[e] * v[e];
        }
#pragma unroll
        for (int i = 0; i < 8; ++i) {
            const size_t rb = (size_t)(t0 + i) * 6144;
            float b[8], c[8], v[8], o[8];
            unpack8(*(const u32x4*)(bcv + rb + c8), b); unpack8(*(const u32x4*)(bcv + rb + 2048 + c8), c); unpack8(*(const u32x4*)(bcv + rb + 4096 + c8), v);
#pragma unroll
            for (int e = 0; e < 8; ++e) { const float u = c[e] * v[e]; o[e] = b[e] * (w0[e] * um2[e] + w1[e] * um1[e] + w2[e] * u); um2[e] = um1[e]; um1[e] = u; }
            *(u32x4*)(z + (size_t)(t0 + i) * D + c8) = pack8f(o);
        }
    }
}

__device__ __forceinline__ f32x4 ld4bf(const bf16* p) { const u32x2 w = *(const u32x2*)p; return (f32x4){__builtin_bit_cast(float, w.x << 16), __builtin_bit_cast(float, w.x & 0xffff0000u), __builtin_bit_cast(float, w.y << 16), __builtin_bit_cast(float, w.y & 0xffff0000u)}; }
__device__ __forceinline__ void pool_phase(const bf16* x, const float* ssq, const float* gain, bf16* out, LAS float* rsl, int G, int tid, int bid) {
    const int ch = tid * 4, w = 2 << (tid >> 7);
    const f32x4 gn = *(const f32x4*)(gain + ch);
    for (int it = bid; it < M / 32; it += G) {
        const int t0 = it * 32, tl0 = t0 & (SEQ - 1);
        __syncthreads();
        if (tid < 48) { const int t = t0 - 16 + tid; float r = 0.f;
            if (t >= 0) { const f32x4* pp = (const f32x4*)(ssq + (size_t)t * 32); f32x4 s4 = pp[0];
#pragma unroll
                for (int j = 1; j < 8; ++j) s4 += pp[j];
                r = __builtin_amdgcn_rsqf(((s4.x + s4.y) + (s4.z + s4.w)) * (1.0f / D) + EPS); }
            rsl[tid] = r; }
        __syncthreads();
        f32x4 s = {0.f, 0.f, 0.f, 0.f};
        for (int j = 1; j < w; ++j) if (tl0 - j >= 0) { const int t = t0 - j; s += ld4bf(x + (size_t)t * D + ch) * gn * rsl[16 - j]; }
#pragma unroll 8
        for (int i = 0; i < 32; ++i) {
            const int t = t0 + i, tl = tl0 + i;
            const f32x4 h = ld4bf(x + (size_t)t * D + ch) * gn * rsl[16 + i];
            s += h;
            const int cnt = (tl + 1 < w) ? tl + 1 : w;
            const f32x4 o = s * (1.0f / (float)cnt) - h;
            u32x2 pw; pw.x = pk2(o.x, o.y); pw.y = pk2(o.z, o.w);
            *(u32x2*)(out + (size_t)t * D + ch) = pw;
            if (tl - w + 1 >= 0) { const int tt = t - w + 1; s -= ld4bf(x + (size_t)tt * D + ch) * gn * rsl[16 + i - w + 1]; }
        }
    }
}

__device__ __forceinline__ void ktile_task(const bf16* src, size_t ld, const float* gain, float extra, bool donorm, bf16* dst, size_t dld, int mode, int lane) {
    const int i = lane & 31, hi = lane >> 5;
    u32x4 v[8];
#pragma unroll
    for (int d0 = 0; d0 < 8; ++d0) v[d0] = *(const u32x4*)(src + (size_t)i * ld + 16 * d0 + 8 * hi);
    if (donorm) {
        float ss = 0.f;
#pragma unroll
        for (int d0 = 0; d0 < 8; ++d0) { float f[8]; unpack8(v[d0], f);
#pragma unroll
            for (int e = 0; e < 8; ++e) ss += f[e] * f[e]; }
        ss += __shfl_xor(ss, 32);
        const float r = __builtin_amdgcn_rsqf(ss * (1.0f / HD) + EPS) * extra;
#pragma unroll
        for (int d0 = 0; d0 < 8; ++d0) { float f[8]; unpack8(v[d0], f);
            const f32x4 g0 = *(const f32x4*)(gain + 16 * d0 + 8 * hi), g1 = *(const f32x4*)(gain + 16 * d0 + 8 * hi + 4);
            f[0] *= r * g0.x; f[1] *= r * g0.y; f[2] *= r * g0.z; f[3] *= r * g0.w; f[4] *= r * g1.x; f[5] *= r * g1.y; f[6] *= r * g1.z; f[7] *= r * g1.w;
            v[d0] = pack8f(f); }
    }
#pragma unroll
    for (int d0 = 0; d0 < 8; ++d0) {
        if (mode == 0) *(u32x4*)(dst + (size_t)i * dld + 16 * d0 + 8 * hi) = v[d0];
        else *(u32x4*)(dst + (size_t)(d0 * 64 + lane) * 8) = v[d0];
    }
}
__device__ __forceinline__ void vtile_task(const bf16* src, size_t ld, bf16* dst, int lane, LAS unsigned char* wl) {
    const int i = lane & 31, hi = lane >> 5, dd = lane & 31;
    u32x4 v[8];
#pragma unroll
    for (int d0 = 0; d0 < 8; ++d0) v[d0] = *(const u32x4*)(src + (size_t)i * ld + 16 * d0 + 8 * hi);
#pragma unroll
    for (int d0 = 0; d0 < 8; ++d0) *(LAS u32x4*)(wl + i * 272 + (16 * d0 + 8 * hi) * 2) = v[d0];
    LDS_WAIT(); asm volatile("" ::: "memory");
#pragma unroll
    for (int sd = 0; sd < 8; ++sd) {
        const int s = sd >> 2, db = sd & 3;
        unsigned hv[8];
#pragma unroll
        for (int e = 0; e < 8; ++e) { const int kk = 16 * s + 8 * (e >> 2) + 4 * hi + (e & 3); hv[e] = *(const LAS unsigned short*)(wl + kk * 272 + (32 * db + dd) * 2); }
        u32x4 w; w.x = hv[0] | (hv[1] << 16); w.y = hv[2] | (hv[3] << 16); w.z = hv[4] | (hv[5] << 16); w.w = hv[6] | (hv[7] << 16);
        *(u32x4*)(dst + (size_t)((s * 4 + db) * 64 + lane) * 8) = w;
    }
    LDS_WAIT(); asm volatile("" ::: "memory");
}
__device__ __forceinline__ void cmp_gemm1_task(unsigned char* ws, int tk, int lane);
struct LT { const bf16* src; size_t ld; const float* gain; float extra; bool donorm; bf16* dst; size_t dld; int mode; };
__device__ __forceinline__ void run_lt(const LT& t, int lane, LAS unsigned char* wl) {
    if (t.mode == 2) vtile_task(t.src, t.ld, t.dst, lane, wl);
    else ktile_task(t.src, t.ld, t.gain, t.extra, t.donorm, t.dst, t.dld, t.mode, lane);
}
__device__ __forceinline__ void prep_phase(const Args& a, LAS unsigned char* lds, int wave, int lane, int G, int bid, const bool nsa) {
    unsigned char* ws = a.ws; const bf16* raw = (const bf16*)(ws + OFF_RAW);
    const int gw = bid * NWAVES + wave, NGW = G * NWAVES;
    constexpr int NT_Q = 256 * 16, NT_G = 2 * 4 * 128, NT_C = 2 * 2 * 64 * 8;
    const int ntask = nsa ? NT_C + NT_Q + 4 * NT_G + 256 : 3 * NT_Q;
    if (nsa && gw < 4) {
        const int which = gw >> 1, n = (gw & 1) * 64 + lane; const float* part = (const float*)(ws + OFF_BIAS1P) + which * 64 * 128 + n;
        float sacc = 0.f;
#pragma unroll 16
        for (int kc = 0; kc < 64; ++kc) sacc += part[kc * 128];
        ((float*)(ws + OFF_BIAS1))[which * 128 + n] = sacc;
    }
    for (int tk = gw; tk < ntask; tk += NGW) {
        LT t; bool gate_task = false; int r = tk;
        if (nsa) {
            if (r < NT_C) { cmp_gemm1_task(ws, r, lane); continue; }
            r -= NT_C;
            if (r < NT_Q) { const int tt = r >> 4, hd = r & 15;
                t = LT{raw + (size_t)tt * 32 * NSA_WP + hd * 128, (size_t)NSA_WP, a.in[9], QSCALE, true, (bf16*)(ws + OFF_QN) + ((size_t)tt * 32 * 16 + hd) * 128, 2048, 0}; }
            else if (r < NT_Q + 4 * NT_G) {
                r -= NT_Q;
                const int kind = 2 + r / NT_G, q = r % NT_G, bg = q >> 7, tile = q & 127, b = bg >> 2, g = bg & 3;
                const bf16* src = raw + ((size_t)b * SEQ + tile * 32) * NSA_WP + 2048 + kind * 512 + g * 128;
                const size_t tofs = ((size_t)bg * 128 + tile) * 4096;
                const size_t doff = kind == 2 ? OFF_KFS : kind == 3 ? OFF_VFS : kind == 4 ? OFF_KFW : OFF_VFW;
                const int mode = (kind & 1) ? 2 : 1;
                t = LT{src, (size_t)NSA_WP, a.in[10] + (kind == 2 ? 128 : 256), 1.f, kind == 2 || kind == 4, (bf16*)(ws + doff) + tofs, 128, mode};
            } else { r -= NT_Q + 4 * NT_G; gate_task = true; }
        } else {
            const int kind = r / NT_Q; r = r % NT_Q;
            if (kind == 0) { const int tt = r >> 4, hd = r & 15;
                t = LT{raw + (size_t)tt * 32 * 6144 + hd * 128, 6144, a.in[18], QSCALE, true, (bf16*)(ws + OFF_QN) + ((size_t)tt * 32 * 16 + hd) * 128, 2048, 0}; }
            else { const int bh = r >> 7, tile = r & 127, b = bh >> 4, hd = bh & 15;
                t = LT{raw + ((size_t)b * SEQ + tile * 32) * 6144 + kind * 2048 + hd * 128, 6144, a.in[19], 1.f, kind == 1, (bf16*)(ws + (kind == 1 ? OFF_KF : OFF_VF)) + ((size_t)bh * 128 + tile) * 4096, 128, kind}; }
        }
        if (gate_task) {
            float* gt = (float*)(ws + OFF_GATE);
            for (int i = lane; i < 32 * 48; i += 64) { const int tq = r * 32 + i / 48, c = i % 48; const float v = bf1(raw[(size_t)tq * NSA_WP + 5120 + c]); gt[(size_t)tq * 48 + c] = 1.0f / (1.0f + __expf(-v)); }
        } else run_lt(t, lane, lds + wave * 8704);
    }
}

__device__ __forceinline__ void cmp_gemm1_task(unsigned char* ws, int tk, int lane) {
    const int i = lane & 31, hi = lane >> 5;
    const int kh = tk >> 10, which = (tk >> 9) & 1, mt = (tk >> 3) & 63, nt = tk & 7;
    const int rr = mt * 32 + i, bg = rr >> 8, j = rr & 255, b = bg >> 2, g = bg & 3;
    const bf16* A = (const bf16*)(ws + OFF_RAW) + (size_t)(b * SEQ + 16 * j) * NSA_WP + 2048 + which * 512 + g * 128 + 8 * hi;
    const bf16* Bt = (const bf16*)(ws + OFF_WC1) + (size_t)which * 256 * 2048 + (size_t)(nt * 32 + i) * 2048 + 8 * hi;
    f32x16 acc;
#pragma unroll
    for (int r = 0; r < 16; ++r) acc[r] = 0.f;
    for (int k8 = 8 * kh; k8 < 8 * kh + 8; ++k8) {
        bf16x8 av[8], bv[8];
#pragma unroll
        for (int jj = 0; jj < 8; ++jj) { av[jj] = *(const bf16x8*)(A + (size_t)k8 * NSA_WP + 16 * jj); bv[jj] = *(const bf16x8*)(Bt + 16 * (8 * k8 + jj)); }
        PIN8(av); PIN8(bv);
#pragma unroll
        for (int jj = 0; jj < 8; ++jj) acc = MFMA32(av[jj], bv[jj], acc);
    }
    float* Y = (float*)(ws + OFF_Y) + (size_t)(which * 2 + kh) * 2048 * 256;
#pragma unroll
    for (int r = 0; r < 16; ++r) Y[(size_t)(mt * 32 + crow(r, hi)) * 256 + nt * 32 + i] = acc[r];
}
__device__ __forceinline__ void cmp_stage2(const Args& a, int wave, int lane, int G, int bid) {
    unsigned char* ws = a.ws; const int gw = bid * NWAVES + wave, NGW = G * NWAVES;
    const float* b1 = (const float*)(ws + OFF_BIAS1);
    for (int tk = gw; tk < 2 * 8 * 256; tk += NGW) {
        const int which = tk >> 11, bg = (tk >> 8) & 7, c = tk & 255;
        float o0 = 0.f, o1 = 0.f;
        if (c < 255) {
            const float* Y = (const float*)(ws + OFF_Y) + (size_t)which * 2 * 2048 * 256 + (size_t)(bg * 256 + c) * 256;
            const float* Yh = Y + (size_t)2048 * 256;
            float p0 = (Y[lane] + Yh[lane]) + (Y[256 + 128 + lane] + Yh[256 + 128 + lane]) + b1[which * 128 + lane];
            float p1 = (Y[64 + lane] + Yh[64 + lane]) + (Y[256 + 128 + 64 + lane] + Yh[256 + 128 + 64 + lane]) + b1[which * 128 + 64 + lane];
            const float a0 = p0 / (1.0f + __expf(-p0)), a1 = p1 / (1.0f + __expf(-p1));
            const float* w2 = a.in[13] + (size_t)which * 128 * 128;
            for (int n = 0; n < 64; ++n) {
                const float x0 = __builtin_bit_cast(float, __builtin_amdgcn_readlane(__builtin_bit_cast(int, a0), n));
                const float x1 = __builtin_bit_cast(float, __builtin_amdgcn_readlane(__builtin_bit_cast(int, a1), n));
                o0 += x0 * w2[n * 128 + lane] + x1 * w2[(64 + n) * 128 + lane];
                o1 += x0 * w2[n * 128 + 64 + lane] + x1 * w2[(64 + n) * 128 + 64 + lane];
            }
            if (which == 0) {
                const float ss = wave_sum(o0 * o0 + o1 * o1); const float r = __builtin_amdgcn_rsqf(ss * (1.0f / HD) + EPS);
                o0 *= r * a.in[10][lane]; o1 *= r * a.in[10][64 + lane];
            }
        }
        const int tile = c >> 5, kk = c & 31;
#pragma unroll
        for (int hf = 0; hf < 2; ++hf) {
            const int d = hf * 64 + lane; const bf16 val = (bf16)f2bf(hf ? o1 : o0);
            if (which == 0) { const int d0 = d >> 4, hh = (d >> 3) & 1, e = d & 7;
                ((bf16*)(ws + OFF_KFC))[((size_t)bg * 8 + tile) * 4096 + (size_t)(d0 * 64 + hh * 32 + kk) * 8 + e] = val; }
            else { const int s = kk >> 4, e = ((kk >> 3) & 1) * 4 + (kk & 3), hh = (kk >> 2) & 1, db = d >> 5, dd = d & 31;
                ((bf16*)(ws + OFF_VFC))[((size_t)bg * 8 + tile) * 4096 + (size_t)((s * 4 + db) * 64 + hh * 32 + dd) * 8 + e] = val; }
        }
    }
}

template <class KP>
__device__ __forceinline__ f32x16 qk_tile(KP Kt, const bf16x8 (&qr)[8], int lane) {
    f32x16 p;
#pragma unroll
    for (int r = 0; r < 16; ++r) p[r] = 0.f;
#pragma unroll
    for (int d0 = 0; d0 < 8; ++d0) p = MFMA32(Kt[d0 * 64 + lane], qr[d0], p);
    return p;
}
template <class VP>
__device__ __forceinline__ void pv_tile(VP Vt, const f32x16& p, f32x16 (&o)[4], int lane) {
    u32x4 w0, w1;
    w0.x = cvtpk(p[0], p[1]); w0.y = cvtpk(p[2], p[3]); w0.z = cvtpk(p[4], p[5]); w0.w = cvtpk(p[6], p[7]);
    w1.x = cvtpk(p[8], p[9]); w1.y = cvtpk(p[10], p[11]); w1.z = cvtpk(p[12], p[13]); w1.w = cvtpk(p[14], p[15]);
    const bf16x8 pf0 = __builtin_bit_cast(bf16x8, w0), pf1 = __builtin_bit_cast(bf16x8, w1);
#pragma unroll
    for (int db = 0; db < 4; ++db) { o[db] = MFMA32(Vt[db * 64 + lane], pf0, o[db]); o[db] = MFMA32(Vt[(4 + db) * 64 + lane], pf1, o[db]); }
}
template <class KP, class VP, class VF>
__device__ __forceinline__ void flash_step(KP Kt, VP Vt, const bf16x8 (&qr)[8], f32x16 (&o)[4], float& m, float& l, int lane, VF valid) {
    f32x16 p = qk_tile(Kt, qr, lane);
    __builtin_amdgcn_sched_barrier(0);
    const int hi = lane >> 5;
    float mx = NEGF;
#pragma unroll
    for (int r = 0; r < 16; ++r) { const bool v = valid(crow(r, hi)); p[r] = v ? p[r] : NEGF; mx = fmaxf(mx, p[r]); }
    mx = fmaxf(mx, __shfl_xor(mx, 32));
    const float mn = fmaxf(m, mx);
    const float alpha = ex2(m - mn);
    m = mn;
    float ls = 0.f;
#pragma unroll
    for (int r = 0; r < 16; ++r) { const float e = (p[r] > -1e29f) ? ex2(p[r] - mn) : 0.f; p[r] = e; ls += e; }
    l = l * alpha + ls;
    if (__any(alpha != 1.0f)) {
#pragma unroll
        for (int db = 0; db < 4; ++db)
#pragma unroll
            for (int r = 0; r < 16; ++r) o[db][r] *= alpha;
    }
    pv_tile(Vt, p, o, lane);
}
template <class VF>
__device__ __forceinline__ void flash_step_lds(const LAS bf16x8* Kt, const LAS bf16x8* Vt, const bf16x8 (&qr)[8], f32x16 (&o)[4], float& m, float& l, int lane, bool rowok, bool need_elem, VF valid) {
    bf16x8 kf[8], vf[8];
#pragma unroll
    for (int d0 = 0; d0 < 8; ++d0) kf[d0] = Kt[d0 * 64 + lane];
    PIN8(kf);
    f32x16 p;
#pragma unroll
    for (int r = 0; r < 16; ++r) p[r] = 0.f;
    __builtin_amdgcn_s_setprio(1);
#pragma unroll
    for (int d0 = 0; d0 < 8; ++d0) p = MFMA32(kf[d0], qr[d0], p);
    __builtin_amdgcn_s_setprio(0);
    __builtin_amdgcn_sched_barrier(0);
#pragma unroll
    for (int i = 0; i < 8; ++i) vf[i] = Vt[i * 64 + lane];
    __builtin_amdgcn_sched_barrier(0);
    const int hi = lane >> 5;
    float mx = NEGF;
    if (need_elem) {
#pragma unroll
        for (int r = 0; r < 16; ++r) { const bool v = rowok && valid(crow(r, hi)); p[r] = v ? p[r] : NEGF; mx = fmaxf(mx, p[r]); }
    } else {
#pragma unroll
        for (int r = 0; r < 16; ++r) { p[r] = rowok ? p[r] : NEGF; mx = fmaxf(mx, p[r]); }
    }
    mx = fmaxf(mx, __shfl_xor(mx, 32));
    if (__any(mx > m + 8.0f)) {
        const float mn = fmaxf(m, mx);
        const float alpha = ex2(m - mn);
        m = mn; l *= alpha;
#pragma unroll
        for (int db = 0; db < 4; ++db)
#pragma unroll
            for (int r = 0; r < 16; ++r) o[db][r] *= alpha;
    }
    float ls = 0.f;
    if (need_elem) {
#pragma unroll
        for (int r = 0; r < 16; ++r) { const float e = (p[r] > -1e29f) ? ex2(p[r] - m) : 0.f; p[r] = e; ls += e; }
    } else {
#pragma unroll
        for (int r = 0; r < 16; ++r) { const float e = ex2(p[r] - m); p[r] = e; ls += e; }
    }
    l += ls;
    u32x4 w0, w1;
    w0.x = cvtpk(p[0], p[1]); w0.y = cvtpk(p[2], p[3]); w0.z = cvtpk(p[4], p[5]); w0.w = cvtpk(p[6], p[7]);
    w1.x = cvtpk(p[8], p[9]); w1.y = cvtpk(p[10], p[11]); w1.z = cvtpk(p[12], p[13]); w1.w = cvtpk(p[14], p[15]);
    const bf16x8 pf0 = __builtin_bit_cast(bf16x8, w0), pf1 = __builtin_bit_cast(bf16x8, w1);
#pragma unroll
    for (int db = 0; db < 4; ++db) { o[db] = MFMA32(vf[db], pf0, o[db]); o[db] = MFMA32(vf[4 + db], pf1, o[db]); }
}
__device__ __forceinline__ void zero_o(f32x16 (&o)[4]) {
#pragma unroll
    for (int db = 0; db < 4; ++db)
#pragma unroll
        for (int r = 0; r < 16; ++r) o[db][r] = 0.f;
}
__device__ __forceinline__ void store_o(const f32x16 (&o)[4], bf16* orow  , int hi) {
#pragma unroll
    for (int db = 0; db < 4; ++db)
#pragma unroll
        for (int gq = 0; gq < 4; ++gq) { u32x2 w; w.x = cvtpk(o[db][4 * gq], o[db][4 * gq + 1]); w.y = cvtpk(o[db][4 * gq + 2], o[db][4 * gq + 3]);
            *(u32x2*)(orow + 32 * db + 8 * gq + 4 * hi) = w; }
}

constexpr size_t OFF_OST2 = OFF_RAW;
constexpr size_t OFF_OST = OFF_H, OFF_SELM = OFF_H + 64 * MiB, OFF_UM = OFF_SELM + 512 * 1024;
__device__ __forceinline__ void nsa_unit(int pp, int half, int& bg, int& tb) { bg = pp & 7; tb = half ? 63 - (pp >> 3) : (pp >> 3); }
__device__ __forceinline__ void load_q(bf16x8 (&qr)[8], const unsigned char* ws, int row, int head, int hi) {
    const bf16* qp = (const bf16*)(ws + OFF_QN) + ((size_t)row * 16 + head) * 128 + 8 * hi;
#pragma unroll
    for (int d0 = 0; d0 < 8; ++d0) qr[d0] = *(const bf16x8*)(qp + 16 * d0);
}
template <class F>
__device__ __forceinline__ void ring_sweep(LAS unsigned char* ring, const unsigned char* Kb, const unsigned char* Vb, unsigned toff, int wave, int Tfirst, int Tmax, unsigned long long um, F f) {
#define RS_NEXT(Tc) ({ int Tn_ = (Tc) + 1; while (Tn_ <= Tmax && !((um >> (Tn_ >> 1)) & 1ull)) ++Tn_; Tn_; })
#define RS_DMA(Tt, slot) do { LAS unsigned char* d_ = ring + (slot) * 16384 + wave * 1024; \
        __builtin_amdgcn_global_load_lds((const unsigned*)(Kb + (unsigned)(Tt) * 8192u + toff), (LAS unsigned*)d_, 16, 0, 0); \
        __builtin_amdgcn_global_load_lds((const unsigned*)(Vb + (unsigned)(Tt) * 8192u + toff), (LAS unsigned*)(d_ + 8192), 16, 0, 0); } while (0)
    __builtin_amdgcn_s_barrier();
    int Ta = Tfirst, Tb = Ta <= Tmax ? RS_NEXT(Ta) : Tmax + 1, Tc = Tb <= Tmax ? RS_NEXT(Tb) : Tmax + 1, slot = 0;
    if (Ta <= Tmax) RS_DMA(Ta, 0);
    if (Tb <= Tmax) RS_DMA(Tb, 1);
    if (Tc <= Tmax) RS_DMA(Tc, 2);
    while (Ta <= Tmax) {
        if (Tc <= Tmax) asm volatile("s_waitcnt vmcnt(4)" ::: "memory");
        else if (Tb <= Tmax) asm volatile("s_waitcnt vmcnt(2)" ::: "memory");
        else asm volatile("s_waitcnt vmcnt(0)" ::: "memory");
        __builtin_amdgcn_s_barrier();
        __builtin_amdgcn_sched_barrier(0);
        const int Td = Tc <= Tmax ? RS_NEXT(Tc) : Tmax + 1;
        if (Td <= Tmax) RS_DMA(Td, (slot + 3) & 3);
        LAS unsigned char* tp = ring + slot * 16384;
        f(Ta, (const LAS bf16x8*)tp, (const LAS bf16x8*)(tp + 8192));
        Ta = Tb; Tb = Tc; Tc = Td; slot = (slot + 1) & 3;
    }
#undef RS_NEXT
#undef RS_DMA
}
__device__ __forceinline__ void nsa_cmp(const Args& a, LAS unsigned char* lds, int wave, int lane, int G, int bid, int tid) {
    unsigned char* ws = a.ws;
    LAS float* impH = (LAS float*)(lds + 65536);
    LAS unsigned long long* ump = (LAS unsigned long long*)(lds + 131072);
    const int q = lane & 31, hi = lane >> 5, h = wave & 3, sub = wave >> 2;
    const float* gates = (const float*)(ws + OFF_GATE);
    const unsigned toff = (unsigned)tid * 16u;
    for (int pp = bid; pp < 256; pp += G)
        for (int half = 0; half < 2; ++half) {
            int bg, tb; nsa_unit(pp, half, bg, tb);
            const int b = bg >> 2, g = bg & 3, unit = bg * 64 + tb;
            const int t0 = tb * 64 + sub * 32, t = t0 + q, row = b * SEQ + t, head = g * 4 + h;
            bf16x8 qr[8]; load_q(qr, ws, row, head, hi);
            f32x16 o[4];
            const unsigned char* Kb = ws + OFF_KFC + (size_t)bg * 8 * 8192;
            const unsigned char* Vb = ws + OFF_VFC + (size_t)bg * 8 * 8192;
            const int nTc = (t0 >> 9) + 1;
            float m = NEGF, l = 0.f;
            zero_o(o);
            ring_sweep(lds, Kb, Vb, toff, wave, 0, nTc - 1, ~0ull, [&](int T, const LAS bf16x8* Kt, const LAS bf16x8* Vt) {
                flash_step_lds(Kt, Vt, qr, o, m, l, lane, true, T >= nTc - 2, [=](int kk) { return 16 * (32 * T + kk) + 31 <= t; }); });
            const float lt = l + __shfl_xor(l, 32);
            {
                unsigned* ostw = (unsigned*)(ws + OFF_OST) + (size_t)(unit * NWAVES + wave) * 2048;
                const float inv = lt > 0.f ? gates[(unsigned)(row * 48 + head * 3 + 0)] / lt : 0.f;
#pragma unroll
                for (int db = 0; db < 4; ++db)
#pragma unroll
                    for (int r = 0; r < 16; r += 2) ostw[(unsigned)((db * 8 + (r >> 1)) * 64 + lane)] = cvtpk(o[db][r] * inv, o[db][r + 1] * inv);
            }
            {
                const float invl = lt > 0.f ? 1.0f / lt : 0.f;
                float prevB = 0.f;
                LAS float* dst = impH + ((sub * 4 + h) * 32 + q) * 64;
                ring_sweep(lds, Kb, Vb, toff, wave, 0, nTc - 1, ~0ull, [&](int T, const LAS bf16x8* Kt, const LAS bf16x8* Vt) {
                    f32x16 p = qk_tile(Kt, qr, lane);
#pragma unroll
                    for (int r = 0; r < 16; ++r) { const bool v = 16 * (32 * T + crow(r, hi)) + 31 <= t; p[r] = v ? ex2(p[r] - m) * invl : 0.f; }
                    float Bp[4];
#pragma unroll
                    for (int gg = 0; gg < 4; ++gg) Bp[gg] = __shfl_xor(p[4 * gg + 3], 32);
#pragma unroll
                    for (int gg = 0; gg < 4; ++gg) {
                        const float A = (p[4 * gg] + p[4 * gg + 1]) + (p[4 * gg + 2] + p[4 * gg + 3]);
                        const float Bv = hi ? Bp[gg] : (gg ? Bp[gg ? gg - 1 : 0] : prevB);
                        dst[8 * T + 2 * gg + hi] = A + Bv;
                    }
                    prevB = Bp[3];
                });
            }
            __syncthreads();
            {
                unsigned long long wm = 0ull;
                unsigned long long* selm = (unsigned long long*)(ws + OFF_SELM) + (size_t)unit * 64;
                for (int jj = 0; jj < 8; ++jj) {
                    const int j = wave * 8 + jj, sj = j >> 5, qj = j & 31, s = lane, cur = tb;
                    float v = 0.f;
                    if (s <= tb) { const LAS float* src = impH + (sj * 4 * 32 + qj) * 64 + s; v = (src[0] + src[32 * 64]) + (src[2 * 32 * 64] + src[3 * 32 * 64]); }
                    const bool valid = s <= cur, forced = (s == 0) || (s == cur) || (s == cur - 1);
                    const float val = forced ? 1e4f : (valid ? v : -1e4f);
                    int rank = 0;
                    for (int jx = 0; jx < 64; ++jx) { const float ov = __builtin_bit_cast(float, __builtin_amdgcn_readlane(__builtin_bit_cast(int, val), jx)); rank += ((ov > val) || (ov == val && jx < lane)) ? 1 : 0; }
                    const unsigned long long mk = __ballot(rank < 16 && valid);
                    if (lane == 0) selm[j] = mk;
                    wm |= mk;
                }
                if (lane == 0) ump[wave] = wm;
            }
            __syncthreads();
            if (wave == 0 && lane == 0) { unsigned long long um = 0ull;
#pragma unroll
                for (int w8 = 0; w8 < 8; ++w8) um |= ump[w8];
                ((unsigned long long*)(ws + OFF_UM))[unit] = um; }
        }
}
template <bool WIN>
__device__ __forceinline__ void nsa_sweep(const Args& a, LAS unsigned char* lds, int wave, int lane, int G, int bid, int tid) {
    unsigned char* ws = a.ws;
    const int q = lane & 31, hi = lane >> 5, h = wave & 3, sub = wave >> 2;
    const float* gates = (const float*)(ws + OFF_GATE);
    const unsigned toff = (unsigned)tid * 16u;
    for (int pp = bid; pp < 256; pp += G)
        for (int half = 0; half < 2; ++half) {
            int bg, tb; nsa_unit(pp, half, bg, tb);
            const int b = bg >> 2, g = bg & 3, unit = bg * 64 + tb;
            const int t0 = tb * 64 + sub * 32, t = t0 + q, row = b * SEQ + t, head = g * 4 + h;
            bf16x8 qr[8]; load_q(qr, ws, row, head, hi);
            unsigned long long msk = ~0ull, um = ~0ull;
            if (!WIN) { msk = ((const unsigned long long*)(ws + OFF_SELM))[(unsigned)(unit * 64 + sub * 32 + q)]; um = ((const unsigned long long*)(ws + OFF_UM))[unit]; }
            const unsigned char* Kb = ws + (WIN ? OFF_KFW : OFF_KFS) + (size_t)bg * 128 * 8192;
            const unsigned char* Vb = ws + (WIN ? OFF_VFW : OFF_VFS) + (size_t)bg * 128 * 8192;
            f32x16 o[4]; zero_o(o);
            float m = NEGF, l = 0.f;
            const int Tmax = 2 * tb + 1;
            const int Tfirst = WIN ? (2 * tb >= 16 ? 2 * tb - 16 : 0) : 0;
            ring_sweep(lds, Kb, Vb, toff, wave, Tfirst, Tmax, um, [&](int T, const LAS bf16x8* Kt, const LAS bf16x8* Vt) {
                const int Td = t0 >> 5;
                if (WIN) flash_step_lds(Kt, Vt, qr, o, m, l, lane, true, (T >= Td) || (T <= Td - 16), [=](int kk) { const int key = 32 * T + kk; return key <= t && t - key < 512; });
                else { const bool bit = (msk >> (T >> 1)) & 1ull;
                    flash_step_lds(Kt, Vt, qr, o, m, l, lane, bit, T >= Td, [=](int kk) { return 32 * T + kk <= t; }); } });
            const float lt = l + __shfl_xor(l, 32);
            const float inv = lt > 0.f ? gates[(unsigned)(row * 48 + head * 3 + (WIN ? 2 : 1))] / lt : 0.f;
            const unsigned* osrc = (const unsigned*)(ws + (WIN ? OFF_OST2 : OFF_OST)) + (size_t)(unit * NWAVES + wave) * 2048;
            int lane2 = lane; asm volatile("" : "+v"(lane2));
            unsigned* ostw = (unsigned*)(ws + OFF_OST2) + (size_t)(unit * NWAVES + wave) * 2048;
#pragma unroll
            for (int db = 0; db < 4; ++db) {
#pragma unroll
                for (int r = 0; r < 16; r += 2) { const unsigned w = osrc[(unsigned)((db * 8 + (r >> 1)) * 64 + lane2)]; o[db][r] = bflo(w) + o[db][r] * inv; o[db][r + 1] = bfhi(w) + o[db][r + 1] * inv; }
                __builtin_amdgcn_sched_barrier(0); }
            if (WIN) store_o(o, (bf16*)(ws + OFF_Z) + (unsigned)(row * D + head * 128), hi);
            else {
#pragma unroll
                for (int db = 0; db < 4; ++db)
#pragma unroll
                    for (int r = 0; r < 16; r += 2) ostw[(unsigned)((db * 8 + (r >> 1)) * 64 + lane)] = cvtpk(o[db][r], o[db][r + 1]);
            }
        }
}

__device__ __forceinline__ void sb_core(const Args& a, int wave, int lane, int G, int bid) {
    unsigned char* ws = a.ws;
    const int q = lane & 31, hi = lane >> 5;
    for (int u = bid; u < 512; u += G) {
        const int bh = u >> 4, tb = u & 15, b = bh >> 4, head = bh & 15;
        const int t0 = tb * 256 + wave * 32, t = t0 + q, row = b * SEQ + t;
        bf16x8 qr[8];
        { const bf16* qp = (const bf16*)(ws + OFF_QN) + ((size_t)row * 16 + head) * 128 + 8 * hi;
#pragma unroll
          for (int d0 = 0; d0 < 8; ++d0) qr[d0] = *(const bf16x8*)(qp + 16 * d0); }
        const bf16x8* Kb = (const bf16x8*)(ws + OFF_KF) + (size_t)bh * 128 * 512;
        const bf16x8* Vb = (const bf16x8*)(ws + OFF_VF) + (size_t)bh * 128 * 512;
        f32x16 o[4]; zero_o(o);
        float carry = 1.0f;
        bf16x8 kf[8];
#pragma unroll
        for (int d0 = 0; d0 < 8; ++d0) kf[d0] = Kb[(size_t)(t0 >> 5) * 512 + d0 * 64 + lane];
        for (int T = t0 >> 5; T >= 0; --T) {
            bf16x8 vf[8];
            PIN8(kf);
#pragma unroll
            for (int i = 0; i < 8; ++i) vf[i] = Vb[(size_t)T * 512 + i * 64 + lane];
            f32x16 p;
#pragma unroll
            for (int r = 0; r < 16; ++r) p[r] = 0.f;
#pragma unroll
            for (int d0 = 0; d0 < 8; ++d0) p = MFMA32(kf[d0], qr[d0], p);
            __builtin_amdgcn_sched_barrier(0);
            {
                const int Tn = T > 0 ? T - 1 : 0;
#pragma unroll
                for (int d0 = 0; d0 < 8; ++d0) kf[d0] = Kb[(size_t)Tn * 512 + d0 * 64 + lane];
            }
            __builtin_amdgcn_sched_barrier(0);
            float rv[16];
#pragma unroll
            for (int r = 0; r < 16; ++r) {
                const int key = 32 * T + crow(r, hi);
                const float e = ex2(fminf(p[r], 80.f)); const float rr = __builtin_amdgcn_rcpf(1.0f + e);
                const bool ok = key < t;
                rv[r] = ok ? rr : 1.0f; p[r] = ok ? e * rr : 0.f;
            }
            float Gp[4], Tt[4];
#pragma unroll
            for (int gg = 0; gg < 4; ++gg) { const float Gm = (rv[4 * gg] * rv[4 * gg + 1]) * (rv[4 * gg + 2] * rv[4 * gg + 3]); Gp[gg] = __shfl_xor(Gm, 32); Tt[gg] = Gm * Gp[gg]; }
            float suf = carry;
#pragma unroll
            for (int gg = 3; gg >= 0; --gg) {
                float w = suf * (hi ? 1.0f : Gp[gg]);
                p[4 * gg + 3] *= w; w *= rv[4 * gg + 3];
                p[4 * gg + 2] *= w; w *= rv[4 * gg + 2];
                p[4 * gg + 1] *= w; w *= rv[4 * gg + 1];
                p[4 * gg] *= w;
                suf *= Tt[gg];
            }
            carry = suf;
            {
                u32x4 w0, w1;
                w0.x = cvtpk(p[0], p[1]); w0.y = cvtpk(p[2], p[3]); w0.z = cvtpk(p[4], p[5]); w0.w = cvtpk(p[6], p[7]);
                w1.x = cvtpk(p[8], p[9]); w1.y = cvtpk(p[10], p[11]); w1.z = cvtpk(p[12], p[13]); w1.w = cvtpk(p[14], p[15]);
                const bf16x8 pf0 = __builtin_bit_cast(bf16x8, w0), pf1 = __builtin_bit_cast(bf16x8, w1);
#pragma unroll
                for (int db = 0; db < 4; ++db) { o[db] = MFMA32(vf[db], pf0, o[db]); o[db] = MFMA32(vf[4 + db], pf1, o[db]); }
            }
            if (!__any(carry > 1e-37f)) break;
        }
        store_o(o, (bf16*)(ws + OFF_Z) + (size_t)row * D + head * 128, hi);
    }
}


#define XB_TMO      128
#define XB_XCNT(j)  (256  + 64 * (j))
#define XB_XSUB(j)  (1280 + 64 * (j))
#define XB_XGEN(j)  (2304 + 64 * (j))
#define XB_TOP      3328
#define XB_TOPGEN   3392
#define XCD_BAR_WORDS 3456
#define XB_SPIN_CAP (1u << 20)
__device__ __forceinline__ unsigned xb_ld(unsigned* p)              { return __hip_atomic_load(p, __ATOMIC_RELAXED, __HIP_MEMORY_SCOPE_AGENT); }
__device__ __forceinline__ unsigned xb_add(unsigned* p, unsigned v) { return __hip_atomic_fetch_add(p, v, __ATOMIC_RELAXED, __HIP_MEMORY_SCOPE_AGENT); }
__device__ __forceinline__ unsigned xb_xcc_id() { return (unsigned)__builtin_amdgcn_s_getreg((3 << 11) | 20) & 0xFu; }
#define XB_SPIN(cond, bar) do { unsigned _sp = 0; while (cond) { __builtin_amdgcn_s_sleep(1); \
    if ((++_sp & 255u) == 0u) { if (xb_ld(&(bar)[XB_TMO])) break; if (_sp > XB_SPIN_CAP) { atomicAdd(&(bar)[XB_TMO], 1u); break; } } } } while (0)
struct XcdBarrier { unsigned* bar; unsigned x; volatile LAS unsigned* st; };
__device__ __forceinline__ XcdBarrier xcd_barrier_post(unsigned* bar, volatile LAS unsigned* st) {
    XcdBarrier b; b.bar = bar; b.x = xb_xcc_id(); b.st = st;
    if (threadIdx.x == 0) (void)xb_add(&bar[XB_XCNT(b.x)], 1u);
    return b;
}
__device__ __forceinline__ void xcd_barrier_complete(unsigned* bar, unsigned x, unsigned& nloc, unsigned& nx) {
    const unsigned G = gridDim.x * gridDim.y * gridDim.z;
    unsigned sum, cnt, mine, sp = 0u;
    for (;;) {
        sum = 0u; cnt = 0u; mine = 0u;
#pragma unroll
        for (unsigned j = 0; j < 16; ++j) { const unsigned c = xb_ld(&bar[XB_XCNT(j)]); sum += c; cnt += (c > 0u) ? 1u : 0u; mine = (j == x) ? c : mine; }
        if (sum == G) break;
        __builtin_amdgcn_s_sleep(1);
        if ((++sp & 255u) == 0u) { if (xb_ld(&bar[XB_TMO])) break; if (sp > XB_SPIN_CAP) { atomicAdd(&bar[XB_TMO], 1u); break; } }
    }
    nloc = mine > 0u ? mine : 1u; nx = cnt > 0u ? cnt : 1u;
}
__device__ __forceinline__ void xcd_barrier(const XcdBarrier& b) {
    asm volatile("s_waitcnt vmcnt(0)" ::: "memory");
    __syncthreads();
    if (threadIdx.x == 0) {
        unsigned* bar = b.bar;
        __builtin_amdgcn_s_waitcnt(0);
        unsigned nloc = b.st[0], nx = b.st[1];
        if (nloc == 0u) { xcd_barrier_complete(bar, b.x, nloc, nx); b.st[0] = nloc; b.st[1] = nx; }
        const unsigned old = xb_add(&bar[XB_XSUB(b.x)], 1u);
        const unsigned gen = old / nloc;
        if (old + 1u == (gen + 1u) * nloc) {
            __builtin_amdgcn_fence(__ATOMIC_RELEASE, "agent");
            asm volatile("s_waitcnt vmcnt(0)" ::: "memory");
            const unsigned og = xb_add(&bar[XB_TOP], 1u);
            const unsigned tg = og / nx;
            if (og + 1u == (tg + 1u) * nx) xb_add(&bar[XB_TOPGEN], 1u);
            else XB_SPIN(xb_ld(&bar[XB_TOPGEN]) == tg, bar);
            __builtin_amdgcn_fence(__ATOMIC_ACQUIRE, "agent");
            xb_add(&bar[XB_XGEN(b.x)], 1u);
            asm volatile("s_waitcnt vmcnt(0)" ::: "memory");
        } else {
            XB_SPIN(xb_ld(&bar[XB_XGEN(b.x)]) == gen, bar);
            __builtin_amdgcn_fence(__ATOMIC_ACQUIRE, "agent");
            asm volatile("s_waitcnt vmcnt(0)" ::: "memory");
        }
    }
    __syncthreads();
}

__device__ __forceinline__ bool gemm_desc(int ph, const Args& a, pg8::Gemm& g, pg8::Epi& E) {
    unsigned char* ws = a.ws;
    bf16* xb = (bf16*)(ws + OFF_XB); bf16* hb = (bf16*)(ws + OFF_H); bf16* raw = (bf16*)(ws + OFF_RAW); bf16* z = (bf16*)(ws + OFF_Z);
    float* ssq = (float*)(ws + OFF_SSQ);
    auto act = [&](const bf16* A, const bf16* Bt, int N, int K, bf16* O, int ldc, const float* sq, int mode) {
        g = pg8::Gemm{A, Bt, M, N, K, K, K, 0}; E = pg8::Epi{mode, O, ldc, sq, nullptr, nullptr, nullptr}; };
    auto res = [&](const bf16* A, const bf16* Bt, int K, int lda, int ldb, int agrp, const float* xin, float* sq_out) {
        g = pg8::Gemm{A, Bt, M, D, K, lda, ldb, agrp}; E = pg8::Epi{2, xb, D, nullptr, xin, ph == 25 ? a.out : nullptr, sq_out}; };
    switch (ph) {
        case 1: act(xb, (const bf16*)(ws + OFF_CIN), 6144, D, raw, 6144, ssq + 0 * SSQ_STRIDE, 0); return true;
        case 3: res(z, (const bf16*)(ws + OFF_COUT), D, D, D, 0, a.in[0], ssq + 1 * SSQ_STRIDE); return true;
        case 4: act(xb, (const bf16*)(ws + OFF_W1T), FF, D, hb, FF, ssq + 1 * SSQ_STRIDE, 1); return true;
        case 5: res(hb, (const bf16*)(ws + OFF_W2T), FF, FF, FF, 0, a.out, ssq + 2 * SSQ_STRIDE); return true;
        case 6: act(xb, (const bf16*)(ws + OFF_NIN), NSA_WP, D, raw, NSA_WP, ssq + 2 * SSQ_STRIDE, 0); return true;
        case 13: res(z, (const bf16*)(ws + OFF_NOUT), D, D, D, 0, a.out, ssq + 3 * SSQ_STRIDE); return true;
        case 14: act(xb, (const bf16*)(ws + OFF_W1T) + (size_t)1 * D * FF, FF, D, hb, FF, ssq + 3 * SSQ_STRIDE, 1); return true;
        case 15: res(hb, (const bf16*)(ws + OFF_W2T) + (size_t)1 * D * FF, FF, FF, FF, 0, a.out, ssq + 4 * SSQ_STRIDE); return true;
        case 17: res(z, (const bf16*)(ws + OFF_POOL), 512, D, 512, 1, a.out, ssq + 5 * SSQ_STRIDE); return true;
        case 18: act(xb, (const bf16*)(ws + OFF_W1T) + (size_t)2 * D * FF, FF, D, hb, FF, ssq + 5 * SSQ_STRIDE, 1); return true;
        case 19: res(hb, (const bf16*)(ws + OFF_W2T) + (size_t)2 * D * FF, FF, FF, FF, 0, a.out, ssq + 6 * SSQ_STRIDE); return true;
        case 20: act(xb, (const bf16*)(ws + OFF_SIN), 6144, D, raw, 6144, ssq + 6 * SSQ_STRIDE, 0); return true;
        case 23: res(z, (const bf16*)(ws + OFF_SOUT), D, D, D, 0, a.out, ssq + 7 * SSQ_STRIDE); return true;
        case 24: act(xb, (const bf16*)(ws + OFF_W1T) + (size_t)3 * D * FF, FF, D, hb, FF, ssq + 7 * SSQ_STRIDE, 1); return true;
        case 25: res(hb, (const bf16*)(ws + OFF_W2T) + (size_t)3 * D * FF, FF, FF, FF, 0, a.out, ssq + 8 * SSQ_STRIDE); return true;
        default: return false;
    }
}

__global__ void __launch_bounds__(NTHREADS, 2) fwd_kernel(Args arg) {
    extern __shared__ __attribute__((aligned(16))) unsigned char lds_raw[];
    LAS unsigned char* lds = (LAS unsigned char*)lds_raw;
    typedef const volatile __attribute__((address_space(4))) unsigned long long* kvptr;
    const int ph_lo = arg.ph_lo, ph_hi = arg.ph_hi;
    volatile LAS unsigned* bst = (volatile LAS unsigned*)(lds + LDS_BYTES - 64);
    if (threadIdx.x < 2) bst[threadIdx.x] = 0u;
    __syncthreads();
    XcdBarrier xbar = xcd_barrier_post((unsigned*)(arg.ws + OFF_CTL), bst);
    for (int pi = ph_lo; pi < ph_hi; ++pi) {
        int ph = 0; if (DUPMASK) { int c = pi; for (;;) { const int reps = ((DUPMASK >> ph) & 1ull) ? 2 : 1; if (c < reps) break; c -= reps; ++ph; } } else ph = pi;
        if (ph == 8) continue;
        Args a;
        { kvptr kp = (kvptr)__builtin_amdgcn_kernarg_segment_ptr();
#pragma unroll
          for (int i = 0; i < 21; ++i) a.in[i] = (const float*)(const __attribute__((address_space(1))) float*)(uintptr_t)kp[i];
          a.out = (float*)(__attribute__((address_space(1))) float*)(uintptr_t)kp[21]; a.ws = (unsigned char*)(__attribute__((address_space(1))) unsigned char*)(uintptr_t)kp[22]; a.ph_lo = ph_lo; a.ph_hi = ph_hi; }
        unsigned char* ws = a.ws;
        int tid = threadIdx.x, G = gridDim.x, bid = blockIdx.x;
        asm volatile("" : "+v"(tid)); asm volatile("" : "+s"(G)); asm volatile("" : "+s"(bid));
        const int lane = tid & 63, wave = __builtin_amdgcn_readfirstlane(tid >> 6);
        pg8::Gemm g; pg8::Epi E;
        if (gemm_desc(ph, a, g, E)) {
            if (PH_EN(100)) {
            pg8::StaticOrder S; S.init(g.M, g.N, G, bid);
            pg8::gemm_phase<true>(lds, g, S, E, tid); }
        } else {
            switch (ph) {
                case 0: if (PH_EN(0)) prologue(a, lds, wave, lane, G, bid); break;
                case 2: if (PH_EN(2)) conv_phase((const bf16*)(ws + OFF_RAW), a.in[6], (bf16*)(ws + OFF_Z), G, tid, bid); break;
                case 7: case 21: if (PH_EN(7)) prep_phase(a, lds, wave, lane, G, bid, ph == 7); break;
                case 9: if (PH_EN(9)) cmp_stage2(a, wave, lane, G, bid); break;
                case 10: if (PH_EN(10)) nsa_cmp(a, lds, wave, lane, G, bid, tid); break;
                case 11: if (PH_EN(11)) nsa_sweep<false>(a, lds, wave, lane, G, bid, tid); break;
                case 12: if (PH_EN(12)) nsa_sweep<true>(a, lds, wave, lane, G, bid, tid); break;
                case 16: if (PH_EN(14)) pool_phase((const bf16*)(ws + OFF_XB), (const float*)(ws + OFF_SSQ) + 4 * SSQ_STRIDE, a.in[1] + 2 * D, (bf16*)(ws + OFF_Z), (LAS float*)lds, G, tid, bid); break;
                case 22: if (PH_EN(20)) sb_core(a, wave, lane, G, bid); break;
                default: break;
            }
        }
        if (pi + 1 < ph_hi) {
            if (ph_hi > 4096) { __syncthreads(); cg::this_grid().sync(); }
            else xcd_barrier(xbar);
        }
    }
}

extern "C" void kernel_launch(void* const* d_in, const int* in_sizes, int n_in, void* d_out, int out_size, void* d_ws, size_t ws_size, hipStream_t stream) {
    static int grid = 0;
    if (grid == 0) {
        if (n_in != 21 || out_size != M * D || ws_size < WS_END) { fprintf(stderr, "kernel_launch: unexpected shapes (n_in %d out %d ws %zu need %zu)\n", n_in, out_size, ws_size, (size_t)WS_END); grid = -1; return; }
        int dev = 0, cus = 0, per_cu = 0;
        hipGetDevice(&dev);
        hipDeviceGetAttribute(&cus, hipDeviceAttributeMultiprocessorCount, dev);
        if (hipFuncSetAttribute((const void*)fwd_kernel, hipFuncAttributeMaxDynamicSharedMemorySize, LDS_BYTES) != hipSuccess) { fprintf(stderr, "kernel_launch: hipFuncSetAttribute failed\n"); grid = -1; return; }
        if (hipOccupancyMaxActiveBlocksPerMultiprocessor(&per_cu, (const void*)fwd_kernel, NTHREADS, LDS_BYTES) != hipSuccess || per_cu < 1) { fprintf(stderr, "kernel_launch: occupancy query says %d\n", per_cu); per_cu = 1; }
        (void)hipGetLastError();
        grid = cus * 1;
        fprintf(stderr, "kernel_launch: cus %d per_cu %d grid %d\n", cus, per_cu, grid);
    }
    if (grid < 0) return;
    Args a{};
    for (int i = 0; i < 21; ++i) a.in[i] = (const float*)d_in[i];
    a.out = (float*)d_out; a.ws = (unsigned char*)d_ws;
    (void)hipMemsetAsync((char*)d_ws + OFF_CTL, 0, 65536, stream);
#if MK_MULTI
    for (int ph = 0; ph < NPH; ++ph) { a.ph_lo = ph; a.ph_hi = ph + 1; hipLaunchKernelGGL(fwd_kernel, dim3(grid), dim3(NTHREADS), LDS_BYTES, stream, a); }
#else
    a.ph_lo = 0; a.ph_hi = NPH + __builtin_popcountll(DUPMASK);
    void* args[] = {&a};
    hipError_t e = hipLaunchCooperativeKernel((const void*)fwd_kernel, dim3(grid), dim3(NTHREADS), args, LDS_BYTES, stream);
    if (e != hipSuccess) fprintf(stderr, "cooperative launch failed: %s (grid %d)\n", hipGetErrorString(e), grid);
#endif
}
```

```cpp
#include <hip/hip_runtime.h>
#include <hip/hip_cooperative_groups.h>
#include <cstdio>
#include <cstdint>
namespace cg = cooperative_groups;

#ifndef MK_MULTI
#define MK_MULTI 0
#endif

#ifndef DUPMASK
#define DUPMASK 0ull
#endif
#ifndef TEST_PH
#define TEST_PH -1
#endif
#define PH_EN(n) (TEST_PH < 0 || TEST_PH == (n))
#define LAS __attribute__((address_space(3)))
typedef unsigned short bf16;
typedef short bf16x8 __attribute__((ext_vector_type(8)));
typedef float f32x4 __attribute__((ext_vector_type(4)));
typedef float f32x16 __attribute__((ext_vector_type(16)));
typedef unsigned u32x4 __attribute__((ext_vector_type(4)));
typedef unsigned u32x2 __attribute__((ext_vector_type(2)));

constexpr int BATCH = 2, SEQ = 4096, D = 2048, M = BATCH * SEQ, FF = 8192, NH = 16, HD = 128;
constexpr int NSA_W = 5168, NSA_WP = 5376;
constexpr float EPS = 1e-6f;
constexpr float NEGF = -1e30f;
constexpr float QSCALE = 0.08838834764831845f * 1.4426950408889634f;

constexpr size_t MiB = 1u << 20;
constexpr size_t OFF_SSQ = 1024ull * 1024 * 738;
constexpr size_t OFF_CTL = 0;
constexpr size_t OFF_BIAS1 = 512 * 1024, OFF_BIAS1P = 512 * 1024 + 4096;
constexpr size_t OFF_W1T = 1 * MiB;
constexpr size_t OFF_W2T = OFF_W1T + 128 * MiB;
constexpr size_t OFF_CIN = OFF_W2T + 128 * MiB;
constexpr size_t OFF_COUT = OFF_CIN + 24 * MiB;
constexpr size_t OFF_NIN = OFF_COUT + 8 * MiB;
constexpr size_t OFF_NOUT = OFF_NIN + 21 * MiB;
constexpr size_t OFF_POOL = OFF_NOUT + 8 * MiB;
constexpr size_t OFF_SIN = OFF_POOL + 2 * MiB;
constexpr size_t OFF_SOUT = OFF_SIN + 24 * MiB;
constexpr size_t OFF_WC1 = OFF_SOUT + 8 * MiB;
constexpr size_t OFF_XB = OFF_WC1 + 2 * MiB;
constexpr size_t OFF_H = OFF_XB + 32 * MiB;
constexpr size_t OFF_RAW = OFF_H + 128 * MiB;
constexpr size_t OFF_Z = OFF_RAW + 96 * MiB;
constexpr size_t OFF_QN = OFF_Z + 32 * MiB;
constexpr size_t OFF_KF = OFF_QN + 32 * MiB;
constexpr size_t OFF_VF = OFF_KF + 32 * MiB;
constexpr size_t WS_END = OFF_VF + 32 * MiB + 16 * MiB;
static_assert(OFF_SSQ == OFF_VF + 32 * MiB, "ssq partials sit after VF");
constexpr int SSQ_STRIDE = M * 32;
constexpr size_t OFF_KFS = OFF_KF, OFF_KFW = OFF_KF + 8 * MiB, OFF_KCG = OFF_KF + 16 * MiB, OFF_VCG = OFF_KF + 24 * MiB;
constexpr size_t OFF_VFS = OFF_VF, OFF_VFW = OFF_VF + 8 * MiB, OFF_Y = OFF_KF + 16 * MiB  , OFF_KFC = OFF_VF + 20 * MiB, OFF_VFC = OFF_VF + 21 * MiB, OFF_GATE = OFF_VF + 22 * MiB;

constexpr int NWAVES = 8, NTHREADS = 512;
constexpr int LDS_BYTES = 147456;
constexpr int NPH = 26;

namespace pg8 {
constexpr int BM = 256, BK = 64, HALF = 128, HTB = HALF * BK * 2, STAGE_BYTES = 8 * HTB, NXCD = 8, WGM = 4;
__device__ __forceinline__ int lds_byte(int r, int c) { const int st = (r >> 4) * 2 + (c >> 5), rr = r & 15, cc = c & 31, ob = rr * 64 + cc * 2; return st * 1024 + (ob ^ (((ob >> 9) & 1) << 5)); }
__device__ __forceinline__ void stage_rc(int b, int& R, int& C) { const int st = b / 1024, sb = b % 1024, swz = sb ^ (((sb >> 9) & 1) << 5); R = (st >> 1) * 16 + swz / 64; C = (st & 1) * 32 + (swz % 64) / 2; }
__device__ __forceinline__ int perm32(int rho) { const int n = rho >> 4, i = rho & 15; return 8 * (i >> 2) + 4 * n + (i & 3); }
struct Unit { int pm, pn; };
struct Gemm { const bf16* A; const bf16* Bt; int M, N, K, lda, ldb, agrp; };
struct StaticOrder {
    int nM, nN, nwg, G, c;
    __device__ void init(int M_, int N_, int G_, int c_) { nM = M_ / BM; nN = N_ / BM; nwg = nM * nN; G = G_; c = c_; }
    __device__ bool next(int i, Unit& u) const {
        const long L = (long)i * G + c; if (L >= nwg) return false;
        int wgid = (int)L; { const int q = nwg / NXCD, r = nwg % NXCD, xcd = wgid % NXCD, off = wgid / NXCD; wgid = (xcd < r ? xcd * (q + 1) : r * (q + 1) + (xcd - r) * q) + off; }
        const int nig = WGM * nM, gid = wgid / nig, fn = gid * WGM, gsz = (nN - fn) < WGM ? (nN - fn) : WGM;
        u.pn = fn + ((wgid % nig) % gsz); u.pm = (wgid % nig) / gsz; return true;
    }
};
__device__ __forceinline__ unsigned cvt_pk_bf16(float lo, float hi) { unsigned r; asm volatile("v_cvt_pk_bf16_f32 %0, %1, %2" : "=v"(r) : "v"(lo), "v"(hi)); return r; }

struct Epi {
    int mode; bf16* O; int ldc; const float* ssq_in; const float* xin; float* xout; float* ssq_out;
    __device__ __forceinline__ void operator()(const f32x4 (&acc)[2][2][4][2], const Unit& u, int wr, int wc, int fr, int fq, int ui, const LAS float* rsl) const {
        const int row0 = u.pm * BM + wr * 64 + fr, col0 = u.pn * BM + wc * 32 + 8 * fq;
        if (mode != 2) {
#pragma unroll
            for (int ai = 0; ai < 2; ++ai)
#pragma unroll
                for (int m = 0; m < 4; ++m) {
                    const int row = row0 + ai * HALF + m * 16;
                    float rs = 1.0f;
                    if (ssq_in && ui < 4) rs = rsl[ui * 256 + ai * HALF + wr * 64 + m * 16 + fr];
                    else if (ssq_in) { const f32x4* pp = (const f32x4*)(ssq_in + (size_t)row * 32); f32x4 s4 = pp[0];
#pragma unroll
                        for (int j = 1; j < 8; ++j) s4 += pp[j];
                        rs = __builtin_amdgcn_rsqf(((s4.x + s4.y) + (s4.z + s4.w)) * (1.0f / D) + EPS); }
                    bf16* rowp = O + (size_t)row * ldc + col0;
#pragma unroll
                    for (int bj = 0; bj < 2; ++bj) {
                        f32x4 v0 = acc[ai][bj][m][0] * rs, v1 = acc[ai][bj][m][1] * rs;
                        if (mode == 1) {
#pragma unroll
                            for (int e = 0; e < 4; ++e) { float a = fmaxf(v0[e], 0.f), b = fmaxf(v1[e], 0.f); v0[e] = a * a; v1[e] = b * b; }
                        }
                        u32x4 w; w.x = cvt_pk_bf16(v0[0], v0[1]); w.y = cvt_pk_bf16(v0[2], v0[3]); w.z = cvt_pk_bf16(v1[0], v1[1]); w.w = cvt_pk_bf16(v1[2], v1[3]);
                        *(u32x4*)(rowp + bj * HALF) = w;
                    }
                }
        } else {
            u32x4 rb[16];
#pragma unroll
            for (int ai = 0; ai < 2; ++ai)
#pragma unroll
                for (int m = 0; m < 4; ++m)
#pragma unroll
                    for (int bj = 0; bj < 2; ++bj) rb[(ai * 4 + m) * 2 + bj] = *(const u32x4*)(O + (size_t)(row0 + ai * HALF + m * 16) * D + col0 + bj * HALF);
            asm volatile("" : "+v"(rb[0]), "+v"(rb[1]), "+v"(rb[2]), "+v"(rb[3]), "+v"(rb[4]), "+v"(rb[5]), "+v"(rb[6]), "+v"(rb[7]));
            asm volatile("" : "+v"(rb[8]), "+v"(rb[9]), "+v"(rb[10]), "+v"(rb[11]), "+v"(rb[12]), "+v"(rb[13]), "+v"(rb[14]), "+v"(rb[15]));
#pragma unroll
            for (int ai = 0; ai < 2; ++ai)
#pragma unroll
                for (int m = 0; m < 4; ++m) {
                    const int row = row0 + ai * HALF + m * 16;
                    float s = 0.f;
#pragma unroll
                    for (int bj = 0; bj < 2; ++bj) {
                        const size_t p = (size_t)row * D + col0 + bj * HALF;
                        const u32x4 rbv = rb[(ai * 4 + m) * 2 + bj];
                        const f32x4 r0 = {__builtin_bit_cast(float, rbv.x << 16), __builtin_bit_cast(float, rbv.x & 0xffff0000u), __builtin_bit_cast(float, rbv.y << 16), __builtin_bit_cast(float, rbv.y & 0xffff0000u)};
                        const f32x4 r1 = {__builtin_bit_cast(float, rbv.z << 16), __builtin_bit_cast(float, rbv.z & 0xffff0000u), __builtin_bit_cast(float, rbv.w << 16), __builtin_bit_cast(float, rbv.w & 0xffff0000u)};
                        const f32x4 v0 = acc[ai][bj][m][0] + r0, v1 = acc[ai][bj][m][1] + r1;
                        if (xout) { *(f32x4*)(xout + p) = v0; *(f32x4*)(xout + p + 4) = v1; }
                        u32x4 w; w.x = cvt_pk_bf16(v0[0], v0[1]); w.y = cvt_pk_bf16(v0[2], v0[3]); w.z = cvt_pk_bf16(v1[0], v1[1]); w.w = cvt_pk_bf16(v1[2], v1[3]);
                        *(u32x4*)(O + p) = w;
                        s += (v0[0] * v0[0] + v0[1] * v0[1]) + (v0[2] * v0[2] + v0[3] * v0[3]) + (v1[0] * v1[0] + v1[1] * v1[1]) + (v1[2] * v1[2] + v1[3] * v1[3]);
                    }
                    s += __shfl_xor(s, 16); s += __shfl_xor(s, 32);
                    if (fq == 0) ssq_out[(size_t)row * 32 + (u.pn & 7) * 4 + wc] = s;
                }
        }
    }
};

template <bool ALIGN_EPI>
__device__ __forceinline__ void gemm_phase(LAS unsigned char* lds, const Gemm g, const StaticOrder& S, const Epi& E, const int tid) {
    const int wid = __builtin_amdgcn_readfirstlane(tid >> 6), lane = tid & 63, wr = wid >> 2, wc = wid & 3, fr = lane & 15, fq = lane >> 4;
    const int K = g.K, nt = K / BK;
    unsigned voffA[2], voffB[2];
#pragma unroll
    for (int i = 0; i < 2; ++i) { int R, C; stage_rc(tid * 16 + i * 8192, R, C); const int Rb = (R & ~31) + perm32(R & 31);
        voffA[i] = (unsigned)(R * g.lda + C) * 2u; voffB[i] = (unsigned)(Rb * g.ldb + C) * 2u; }
    LAS float* rsl = (LAS float*)(lds + STAGE_BYTES);
    const size_t kstep = (size_t)(BK * 2);
    const size_t hstepA = (size_t)HALF * g.lda * 2, hstepB = (size_t)HALF * g.ldb * 2;
    const unsigned ldsw = (unsigned)wid * 1024u;
    const int aoff = lds_byte(wr * 64 + fr, fq * 8), boff = lds_byte(wc * 32 + fr, fq * 8);
#define PG8_SA(b, h) (((b) * 2 + (h)) * HTB)
#define PG8_SB(b, h) ((4 + (b) * 2 + (h)) * HTB)
#define PG8_STAGE(bufoff, gbase, voff) do { _Pragma("unroll") for (int _i = 0; _i < 2; ++_i) \
        __builtin_amdgcn_global_load_lds((const unsigned*)((const char*)(gbase) + (voff)[_i]), (LAS unsigned*)(lds + (bufoff) + ldsw + _i * 8192), 16, 0, 0); } while (0)
#define PG8_LDA(dst, b, h) do { _Pragma("unroll") for (int m = 0; m < 4; ++m) _Pragma("unroll") for (int k = 0; k < 2; ++k) dst[m][k] = *(const LAS bf16x8*)(lds + PG8_SA(b, h) + aoff + m * 2048 + k * 1024); } while (0)
#define PG8_LDB(dst, b, h) do { _Pragma("unroll") for (int n = 0; n < 2; ++n) _Pragma("unroll") for (int k = 0; k < 2; ++k) dst[n][k] = *(const LAS bf16x8*)(lds + PG8_SB(b, h) + boff + n * 2048 + k * 1024); } while (0)
#define PG8_MMA(ai, bj, At, Bt) do { __builtin_amdgcn_s_setprio(1); _Pragma("unroll") for (int m = 0; m < 4; ++m) _Pragma("unroll") for (int n = 0; n < 2; ++n) _Pragma("unroll") for (int k = 0; k < 2; ++k) \
        acc[ai][bj][m][n] = __builtin_amdgcn_mfma_f32_16x16x32_bf16(Bt[n][k], At[m][k], acc[ai][bj][m][n], 0, 0, 0); __builtin_amdgcn_s_setprio(0); } while (0)
#define PG8_WAIT_V(n) asm volatile("s_waitcnt vmcnt(" #n ")" ::: "memory")
#define PG8_WAIT_L(n) asm volatile("s_waitcnt lgkmcnt(" #n ")" ::: "memory")
#define PG8_BAR __builtin_amdgcn_s_barrier()
#define PG8_SCHED __builtin_amdgcn_sched_barrier(0)
    Unit cur, nxt; int ui = 0;
    if (!S.next(0, cur)) return;
    f32x4 acc[2][2][4][2];
#pragma unroll
    for (int a = 0; a < 2; ++a)
#pragma unroll
        for (int b = 0; b < 2; ++b)
#pragma unroll
            for (int m = 0; m < 4; ++m)
#pragma unroll
                for (int n = 0; n < 2; ++n) acc[a][b][m][n] = (f32x4){0.f, 0.f, 0.f, 0.f};
    bf16x8 At[4][2], B0[2][2], B1[2][2];
    const char* cA = (const char*)g.A + (size_t)cur.pm * 2 * hstepA + (g.agrp ? (size_t)(cur.pn >> 1) * 1024 : 0);
    const char* cB = (const char*)g.Bt + (size_t)cur.pn * 2 * hstepB;
    PG8_STAGE(PG8_SB(0, 0), cB, voffB); PG8_STAGE(PG8_SB(0, 1), cB + hstepB, voffB); PG8_STAGE(PG8_SA(0, 0), cA, voffA); PG8_STAGE(PG8_SA(0, 1), cA + hstepA, voffA);
    if (E.mode != 2 && E.ssq_in) {
        for (int i = tid; i < 4 * 256; i += 512) { Unit uu;
            if (S.next(i >> 8, uu)) { const f32x4* pp = (const f32x4*)(E.ssq_in + (size_t)(uu.pm * BM + (i & 255)) * 32); f32x4 s4 = pp[0];
#pragma unroll
                for (int j = 1; j < 8; ++j) s4 += pp[j];
                rsl[i] = __builtin_amdgcn_rsqf(((s4.x + s4.y) + (s4.z + s4.w)) * (1.0f / D) + EPS); } }
    }
    if (wr == 1) PG8_BAR;
    PG8_WAIT_V(2); PG8_BAR;
    PG8_STAGE(PG8_SB(1, 0), cB + kstep, voffB); PG8_STAGE(PG8_SA(1, 0), cA + kstep, voffA); PG8_STAGE(PG8_SB(1, 1), cB + hstepB + kstep, voffB);
    PG8_WAIT_V(6); PG8_BAR;
    for (;;) {
        const bool has_next = S.next(ui + 1, nxt);
        const char* nA = has_next ? (const char*)g.A + (size_t)nxt.pm * 2 * hstepA + (g.agrp ? (size_t)(nxt.pn >> 1) * 1024 : 0) : cA;
        const char* nB = has_next ? (const char*)g.Bt + (size_t)nxt.pn * 2 * hstepB : cB;
        for (int t = 0; t < nt; t += 2) {
            const bool last = (t == nt - 2);
            const char* a1 = cA + (size_t)(t + 1) * kstep;
            const char* a2 = last ? nA : cA + (size_t)(t + 2) * kstep; const char* b2 = last ? nB : cB + (size_t)(t + 2) * kstep;
            const char* a3 = a2 + kstep; const char* b3 = b2 + kstep;
            PG8_LDB(B0, 0, 0); PG8_LDB(B1, 0, 1); PG8_SCHED; PG8_LDA(At, 0, 0); PG8_STAGE(PG8_SA(1, 1), a1 + hstepA, voffA);
            PG8_WAIT_V(8); PG8_WAIT_L(0); PG8_BAR; PG8_MMA(0, 0, At, B0); PG8_MMA(0, 1, At, B1); PG8_BAR; PG8_SCHED;
            PG8_LDA(At, 0, 1); PG8_STAGE(PG8_SB(0, 0), b2, voffB); PG8_STAGE(PG8_SB(0, 1), b2 + hstepB, voffB); PG8_STAGE(PG8_SA(0, 0), a2, voffA);
            PG8_WAIT_V(8); PG8_WAIT_L(0); PG8_BAR; PG8_MMA(1, 0, At, B0); PG8_MMA(1, 1, At, B1); PG8_BAR; PG8_SCHED;
            PG8_LDB(B0, 1, 0); PG8_LDB(B1, 1, 1); PG8_SCHED; PG8_LDA(At, 1, 0); PG8_STAGE(PG8_SA(0, 1), a2 + hstepA, voffA);
            PG8_WAIT_V(8); PG8_WAIT_L(0); PG8_BAR; PG8_MMA(0, 0, At, B0); PG8_MMA(0, 1, At, B1); PG8_BAR; PG8_SCHED;
            PG8_LDA(At, 1, 1); PG8_STAGE(PG8_SB(1, 0), b3, voffB); PG8_STAGE(PG8_SB(1, 1), b3 + hstepB, voffB); PG8_STAGE(PG8_SA(1, 0), a3, voffA);
            PG8_WAIT_V(8); PG8_WAIT_L(0); PG8_BAR; PG8_MMA(1, 0, At, B0); PG8_MMA(1, 1, At, B1); PG8_BAR; PG8_SCHED;
        }
        if constexpr (ALIGN_EPI) { if (wr == 0) PG8_BAR; }
        E(acc, cur, wr, wc, fr, fq, ui, rsl);
        if (!has_next) break;
#pragma unroll
        for (int a = 0; a < 2; ++a)
#pragma unroll
            for (int b = 0; b < 2; ++b)
#pragma unroll
                for (int m = 0; m < 4; ++m)
#pragma unroll
                    for (int n = 0; n < 2; ++n) acc[a][b][m][n] = (f32x4){0.f, 0.f, 0.f, 0.f};
        cur = nxt; cA = nA; cB = nB; ++ui;
        if constexpr (ALIGN_EPI) { if (wr == 1) PG8_BAR; }
    }
    PG8_WAIT_V(0);
    if constexpr (!ALIGN_EPI) { if (wr == 0) PG8_BAR; }
    PG8_BAR;
#undef PG8_SA
#undef PG8_SB
#undef PG8_STAGE
#undef PG8_LDA
#undef PG8_LDB
#undef PG8_MMA
#undef PG8_WAIT_V
#undef PG8_WAIT_L
#undef PG8_BAR
#undef PG8_SCHED
}
}

#define LDS_WAIT() asm volatile("s_waitcnt lgkmcnt(0)" ::: "memory")
__device__ __forceinline__ unsigned f2bf(float f) { unsigned u = __builtin_bit_cast(unsigned, f); return (u + 0x7fffu + ((u >> 16) & 1u)) >> 16; }
typedef float f32x2_t __attribute__((ext_vector_type(2))); typedef __bf16 bf16x2_t __attribute__((ext_vector_type(2)));
__device__ __forceinline__ unsigned pk2(float lo, float hi) { f32x2_t v = {lo, hi}; bf16x2_t b = __builtin_convertvector(v, bf16x2_t); return __builtin_bit_cast(unsigned, b); }
__device__ __forceinline__ float bflo(unsigned w) { return __builtin_bit_cast(float, w << 16); }
__device__ __forceinline__ float bfhi(unsigned w) { return __builtin_bit_cast(float, w & 0xffff0000u); }
__device__ __forceinline__ float bf1(bf16 h) { return __builtin_bit_cast(float, (unsigned)h << 16); }
__device__ __forceinline__ void unpack8(const u32x4 v, float (&f)[8]) { f[0] = bflo(v.x); f[1] = bfhi(v.x); f[2] = bflo(v.y); f[3] = bfhi(v.y); f[4] = bflo(v.z); f[5] = bfhi(v.z); f[6] = bflo(v.w); f[7] = bfhi(v.w); }
__device__ __forceinline__ u32x4 pack8f(const float (&f)[8]) { u32x4 w; w.x = pk2(f[0], f[1]); w.y = pk2(f[2], f[3]); w.z = pk2(f[4], f[5]); w.w = pk2(f[6], f[7]); return w; }
__device__ __forceinline__ float wave_sum(float v) {
#pragma unroll
    for (int o = 1; o < 64; o <<= 1) v += __shfl_xor(v, o);
    return v;
}
__device__ __forceinline__ unsigned cvtpk(float lo, float hi) { f32x2_t v = {lo, hi}; bf16x2_t b = __builtin_convertvector(v, bf16x2_t); return __builtin_bit_cast(unsigned, b); }
#define PIN8(a) asm volatile("" : "+v"(a[0]), "+v"(a[1]), "+v"(a[2]), "+v"(a[3]), "+v"(a[4]), "+v"(a[5]), "+v"(a[6]), "+v"(a[7]))
#define MFMA32(a, b, c) __builtin_amdgcn_mfma_f32_32x32x16_bf16((a), (b), (c), 0, 0, 0)
__device__ __forceinline__ int crow(int r, int hi) { return (r & 3) + 8 * (r >> 2) + 4 * hi; }
__device__ __forceinline__ float ex2(float x) { return __builtin_amdgcn_exp2f(x); }

constexpr int TR_SCR = 64 * 65 * 4;
__device__ __forceinline__ void tr_item(const float* W, int K, int N, bf16* WT, int ldw, int row_off, const float* ksc, const float* nsc, LAS float* scr, int item, int lane) {
    const int nblk = (N + 63) / 64;
    int kb, nb;
    if ((nblk & 3) == 0) { const int q = item >> 3, w = item & 7, nq = nblk >> 2; nb = (q % nq) * 4 + (w & 3); kb = (q / nq) * 2 + (w >> 2); }
    else { kb = item / nblk; nb = item % nblk; }
    const int k0 = 64 * kb, n0 = 64 * nb;
    const int nn = n0 + 4 * (lane & 15), kr = lane >> 4; const bool nok = nn < N;
    f32x4 ns = {1.f, 1.f, 1.f, 1.f};
    if (nsc && nok) ns = *(const f32x4*)(nsc + nn);
    f32x4 v[16];
#pragma unroll
    for (int i = 0; i < 16; ++i) v[i] = nok ? *(const f32x4*)(W + (size_t)(k0 + 4 * i + kr) * N + nn) : (f32x4){0.f, 0.f, 0.f, 0.f};
#pragma unroll
    for (int i = 0; i < 16; ++i) { const int kk = 4 * i + kr; f32x4 x = v[i] * ns; if (ksc) x = x * ksc[k0 + kk];
        LAS float* d = scr + kk * 65 + 4 * (lane & 15); d[0] = x.x; d[1] = x.y; d[2] = x.z; d[3] = x.w; }
    LDS_WAIT(); asm volatile("" ::: "memory");
    const int c = lane & 7;
#pragma unroll
    for (int j = 0; j < 8; ++j) { const int n = (lane >> 3) + 8 * j; const LAS float* sp = scr + (8 * c) * 65 + n;
        u32x4 o; o.x = pk2(sp[0 * 65], sp[1 * 65]); o.y = pk2(sp[2 * 65], sp[3 * 65]); o.z = pk2(sp[4 * 65], sp[5 * 65]); o.w = pk2(sp[6 * 65], sp[7 * 65]);
        if (n0 + n < N) *(u32x4*)(WT + (size_t)(row_off + n0 + n) * ldw + k0 + 8 * c) = o; }
    LDS_WAIT(); asm volatile("" ::: "memory");
}

struct Args { const float* in[21]; float* out; unsigned char* ws; int ph_lo, ph_hi; };

__device__ __forceinline__ void prologue(const Args& a, LAS unsigned char* lds, int wave, int lane, int G, int bid) {
    LAS float* scr = (LAS float*)(lds + wave * TR_SCR);
    const int gw = bid * NWAVES + wave, NGW = G * NWAVES;
    unsigned char* ws = a.ws;
    const float* mixn = a.in[1]; const float* mlpn = a.in[2];
    constexpr int I_W1 = (D / 64) * (FF / 64), I_W2 = (FF / 64) * (D / 64), I_IN = (D / 64) * (6144 / 64), I_SQ = (D / 64) * (D / 64),
                  I_NIN = (D / 64) * ((NSA_W + 63) / 64), I_POOL = (512 / 64) * (512 / 64), I_C1 = (2048 / 64) * (128 / 64);
    constexpr int NITEMS = 4 * I_W1 + 4 * I_W2 + 2 * I_IN + 3 * I_SQ + I_NIN + 4 * I_POOL + 4 * I_C1;
    for (int it = gw; it < NITEMS; it += NGW) {
        int r = it;
        if (r < 4 * I_W1) { const int l = r / I_W1; tr_item(a.in[3] + (size_t)l * D * FF, D, FF, (bf16*)(ws + OFF_W1T) + (size_t)l * D * FF, D, 0, mlpn + l * D, nullptr, scr, r % I_W1, lane); continue; } r -= 4 * I_W1;
        if (r < 4 * I_W2) { const int l = r / I_W2; tr_item(a.in[4] + (size_t)l * D * FF, FF, D, (bf16*)(ws + OFF_W2T) + (size_t)l * D * FF, FF, 0, nullptr, nullptr, scr, r % I_W2, lane); continue; } r -= 4 * I_W2;
        if (r < I_IN) { tr_item(a.in[5], D, 6144, (bf16*)(ws + OFF_CIN), D, 0, mixn + 0 * D, nullptr, scr, r, lane); continue; } r -= I_IN;
        if (r < I_IN) { tr_item(a.in[17], D, 6144, (bf16*)(ws + OFF_SIN), D, 0, mixn + 3 * D, nullptr, scr, r, lane); continue; } r -= I_IN;
        if (r < I_SQ) { tr_item(a.in[7], D, D, (bf16*)(ws + OFF_COUT), D, 0, nullptr, nullptr, scr, r, lane); continue; } r -= I_SQ;
        if (r < I_SQ) { tr_item(a.in[14], D, D, (bf16*)(ws + OFF_NOUT), D, 0, nullptr, nullptr, scr, r, lane); continue; } r -= I_SQ;
        if (r < I_SQ) { tr_item(a.in[20], D, D, (bf16*)(ws + OFF_SOUT), D, 0, nullptr, nullptr, scr, r, lane); continue; } r -= I_SQ;
        if (r < I_NIN) { tr_item(a.in[8], D, NSA_W, (bf16*)(ws + OFF_NIN), D, 0, mixn + 1 * D, nullptr, scr, r, lane); continue; } r -= I_NIN;
        if (r < 4 * I_POOL) { const int gq = r / I_POOL; tr_item(a.in[15] + (size_t)gq * 512 * 512, 512, 512, (bf16*)(ws + OFF_POOL), 512, gq * 512, nullptr, a.in[16] + gq * 512, scr, r % I_POOL, lane); continue; } r -= 4 * I_POOL;
        { const int q = r / I_C1, which = q >> 1, half = q & 1;
          tr_item(a.in[12] + (size_t)which * 4096 * 128 + (size_t)half * 2048 * 128, 2048, 128, (bf16*)(ws + OFF_WC1) + (size_t)which * 256 * 2048, 2048, half * 128, nullptr, nullptr, scr, r % I_C1, lane); }
    }
    {
        const float* x = a.in[0]; bf16* xb = (bf16*)(ws + OFF_XB); float* ssq = (float*)(ws + OFF_SSQ);
        for (int m = gw; m < M; m += NGW) {
            const f32x4* xr = (const f32x4*)(x + (size_t)m * D) + lane; f32x4 v[8]; float s = 0.f;
#pragma unroll
            for (int j = 0; j < 8; ++j) { v[j] = xr[64 * j]; s += (v[j].x * v[j].x + v[j].y * v[j].y) + (v[j].z * v[j].z + v[j].w * v[j].w); }
            s = wave_sum(s);
            if (lane < 32) ssq[(size_t)m * 32 + lane] = lane == 0 ? s : 0.f;
            u32x2* o8 = (u32x2*)(xb + (size_t)m * D) + lane;
#pragma unroll
            for (int j = 0; j < 8; ++j) { u32x2 w; w.x = pk2(v[j].x, v[j].y); w.y = pk2(v[j].z, v[j].w); o8[64 * j] = w; }
        }
    }
    {
        u32x4* p = (u32x4*)((bf16*)(ws + OFF_NIN) + (size_t)NSA_W * D); const int n16 = (NSA_WP - NSA_W) * D * 2 / 16;
        for (int i = gw * 64 + lane; i < n16; i += NGW * 64) p[i] = (u32x4){0u, 0u, 0u, 0u};
    }
    {
        float* part = (float*)(ws + OFF_BIAS1P);
        for (int t = gw; t < 256; t += NGW) {
            const int which = t >> 7, kc = (t >> 1) & 63, n = (t & 1) * 64 + lane;
            const float* pos = a.in[11] + (size_t)which * 4096 + kc * 64; const float* w1 = a.in[12] + (size_t)which * 4096 * 128 + (size_t)kc * 64 * 128 + n;
            float s = 0.f;
#pragma unroll 16
            for (int i = 0; i < 64; ++i) s += pos[i] * w1[i * 128];
            part[(which * 64 + kc) * 128 + n] = s;
        }
    }
}

__device__ __forceinline__ void conv_phase(const bf16* bcv, const float* cw, bf16* z, int G, int tid, int bid) {
    const int half = tid >> 8, c8 = (tid & 255) * 8;
    float w0[8], w1[8], w2[8];
#pragma unroll
    for (int e = 0; e < 8; ++e) { w0[e] = cw[c8 + e]; w1[e] = cw[D + c8 + e]; w2[e] = cw[2 * D + c8 + e]; }
    for (int it = bid; it < M / 16; it += G) {
        const int t0 = it * 16 + half * 8;
        float um2[8], um1[8];
#pragma unroll
        for (int e = 0; e < 8; ++e) { um2[e] = 0.f; um1[e] = 0.f; }
        if ((t0 & (SEQ - 1)) >= 2) {
            float c[8], v[8];
            unpack8(*(const u32x4*)(bcv + (size_t)(t0 - 2) * 6144 + 2048 + c8), c); unpack8(*(const u32x4*)(bcv + (size_t)(t0 - 2) * 6144 + 4096 + c8), v);
#pragma unroll
            for (int e = 0; e < 8; ++e) um2[e] = c[e] * v[e];
            unpack8(*(const u32x4*)(bcv + (size_t)(t0 - 1) * 6144 + 2048 + c8), c); unpack8(*(const u32x4*)(bcv + (size_t)(t0 - 1) * 6144 + 4096 + c8), v);
#pragma unroll
            for (int e = 0; e < 8; ++e) um1[e] = c[e] * v[e];
        }
#pragma unroll
        for (int i = 0; i < 8; ++i) {
            const size_t rb = (size_t)(t0 + i) * 6144;
            float b[8], c[8], v[8], o[8];
            unpack8(*(const u32x4*)(bcv + rb + c8), b); unpack8(*(const u32x4*)(bcv + rb + 2048 + c8), c); unpack8(*(const u32x4*)(bcv + rb + 4096 + c8), v);
#pragma unroll
            for (int e = 0; e < 8; ++e) { const float u = c[e] * v[e]; o[e] = b[e] * (w0[e] * um2[e] + w1[e] * um1[e] + w2[e] * u); um2[e] = um1[e]; um1[e] = u; }
            *(u32x4*)(z + (size_t)(t0 + i) * D + c8) = pack8f(o);
        }
    }
}

__device__ __forceinline__ f32x4 ld4bf(const bf16* p) { const u32x2 w = *(const u32x2*)p; return (f32x4){__builtin_bit_cast(float, w.x << 16), __builtin_bit_cast(float, w.x & 0xffff0000u), __builtin_bit_cast(float, w.y << 16), __builtin_bit_cast(float, w.y & 0xffff0000u)}; }
__device__ __forceinline__ void pool_phase(const bf16* x, const float* ssq, const float* gain, bf16* out, LAS float* rsl, int G, int tid, int bid) {
    const int ch = tid * 4, w = 2 << (tid >> 7);
    const f32x4 gn = *(const f32x4*)(gain + ch);
    for (int it = bid; it < M / 32; it += G) {
        const int t0 = it * 32, tl0 = t0 & (SEQ - 1);
        __syncthreads();
        if (tid < 48) { const int t = t0 - 16 + tid; float r = 0.f;
            if (t >= 0) { const f32x4* pp = (const f32x4*)(ssq + (size_t)t * 32); f32x4 s4 = pp[0];
#pragma unroll
                for (int j = 1; j < 8; ++j) s4 += pp[j];
                r = __builtin_amdgcn_rsqf(((s4.x + s4.y) + (s4.z + s4.w)) * (1.0f / D) + EPS); }
            rsl[tid] = r; }
        __syncthreads();
        f32x4 s = {0.f, 0.f, 0.f, 0.f};
        for (int j = 1; j < w; ++j) if (tl0 - j >= 0) { const int t = t0 - j; s += ld4bf(x + (size_t)t * D + ch) * gn * rsl[16 - j]; }
#pragma unroll 8
        for (int i = 0; i < 32; ++i) {
            const int t = t0 + i, tl = tl0 + i;
            const f32x4 h = ld4bf(x + (size_t)t * D + ch) * gn * rsl[16 + i];
            s += h;
            const int cnt = (tl + 1 < w) ? tl + 1 : w;
            const f32x4 o = s * (1.0f / (float)cnt) - h;
            u32x2 pw; pw.x = pk2(o.x, o.y); pw.y = pk2(o.z, o.w);
            *(u32x2*)(out + (size_t)t * D + ch) = pw;
            if (tl - w + 1 >= 0) { const int tt = t - w + 1; s -= ld4bf(x + (size_t)tt * D + ch) * gn * rsl[16 + i - w + 1]; }
        }
    }
}

__device__ __forceinline__ void ktile_task(const bf16* src, size_t ld, const float* gain, float extra, bool donorm, bf16* dst, size_t dld, int mode, int lane) {
    const int i = lane & 31, hi = lane >> 5;
    u32x4 v[8];
#pragma unroll
    for (int d0 = 0; d0 < 8; ++d0) v[d0] = *(const u32x4*)(src + (size_t)i * ld + 16 * d0 + 8 * hi);
    if (donorm) {
        float ss = 0.f;
#pragma unroll
        for (int d0 = 0; d0 < 8; ++d0) { float f[8]; unpack8(v[d0], f);
#pragma unroll
            for (int e = 0; e < 8; ++e) ss += f[e] * f[e]; }
        ss += __shfl_xor(ss, 32);
        const float r = __builtin_amdgcn_rsqf(ss * (1.0f / HD) + EPS) * extra;
#pragma unroll
        for (int d0 = 0; d0 < 8; ++d0) { float f[8]; unpack8(v[d0], f);
            const f32x4 g0 = *(const f32x4*)(gain + 16 * d0 + 8 * hi), g1 = *(const f32x4*)(gain + 16 * d0 + 8 * hi + 4);
            f[0] *= r * g0.x; f[1] *= r * g0.y; f[2] *= r * g0.z; f[3] *= r * g0.w; f[4] *= r * g1.x; f[5] *= r * g1.y; f[6] *= r * g1.z; f[7] *= r * g1.w;
            v[d0] = pack8f(f); }
    }
#pragma unroll
    for (int d0 = 0; d0 < 8; ++d0) {
        if (mode == 0) *(u32x4*)(dst + (size_t)i * dld + 16 * d0 + 8 * hi) = v[d0];
        else *(u32x4*)(dst + (size_t)(d0 * 64 + lane) * 8) = v[d0];
    }
}
__device__ __forceinline__ void vtile_task(const bf16* src, size_t ld, bf16* dst, int lane, LAS unsigned char* wl) {
    const int i = lane & 31, hi = lane >> 5, dd = lane & 31;
    u32x4 v[8];
#pragma unroll
    for (int d0 = 0; d0 < 8; ++d0) v[d0] = *(const u32x4*)(src + (size_t)i * ld + 16 * d0 + 8 * hi);
#pragma unroll
    for (int d0 = 0; d0 < 8; ++d0) *(LAS u32x4*)(wl + i * 272 + (16 * d0 + 8 * hi) * 2) = v[d0];
    LDS_WAIT(); asm volatile("" ::: "memory");
#pragma unroll
    for (int sd = 0; sd < 8; ++sd) {
        const int s = sd >> 2, db = sd & 3;
        unsigned hv[8];
#pragma unroll
        for (int e = 0; e < 8; ++e) { const int kk = 16 * s + 8 * (e >> 2) + 4 * hi + (e & 3); hv[e] = *(const LAS unsigned short*)(wl + kk * 272 + (32 * db + dd) * 2); }
        u32x4 w; w.x = hv[0] | (hv[1] << 16); w.y = hv[2] | (hv[3] << 16); w.z = hv[4] | (hv[5] << 16); w.w = hv[6] | (hv[7] << 16);
        *(u32x4*)(dst + (size_t)((s * 4 + db) * 64 + lane) * 8) = w;
    }
    LDS_WAIT(); asm volatile("" ::: "memory");
}
__device__ __forceinline__ void cmp_gemm1_task(unsigned char* ws, int tk, int lane);
struct LT { const bf16* src; size_t ld; const float* gain; float extra; bool donorm; bf16* dst; size_t dld; int mode; };
__device__ __forceinline__ void run_lt(const LT& t, int lane, LAS unsigned char* wl) {
    if (t.mode == 2) vtile_task(t.src, t.ld, t.dst, lane, wl);
    else ktile_task(t.src, t.ld, t.gain, t.extra, t.donorm, t.dst, t.dld, t.mode, lane);
}
__device__ __forceinline__ void prep_phase(const Args& a, LAS unsigned char* lds, int wave, int lane, int G, int bid, const bool nsa) {
    unsigned char* ws = a.ws; const bf16* raw = (const bf16*)(ws + OFF_RAW);
    const int gw = bid * NWAVES + wave, NGW = G * NWAVES;
    constexpr int NT_Q = 256 * 16, NT_G = 2 * 4 * 128, NT_C = 2 * 2 * 64 * 8;
    const int ntask = nsa ? NT_C + NT_Q + 4 * NT_G + 256 : 3 * NT_Q;
    if (nsa && gw < 4) {
        const int which = gw >> 1, n = (gw & 1) * 64 + lane; const float* part = (const float*)(ws + OFF_BIAS1P) + which * 64 * 128 + n;
        float sacc = 0.f;
#pragma unroll 16
        for (int kc = 0; kc < 64; ++kc) sacc += part[kc * 128];
        ((float*)(ws + OFF_BIAS1))[which * 128 + n] = sacc;
    }
    for (int tk = gw; tk < ntask; tk += NGW) {
        LT t; bool gate_task = false; int r = tk;
        if (nsa) {
            if (r < NT_C) { cmp_gemm1_task(ws, r, lane); continue; }
            r -= NT_C;
            if (r < NT_Q) { const int tt = r >> 4, hd = r & 15;
                t = LT{raw + (size_t)tt * 32 * NSA_WP + hd * 128, (size_t)NSA_WP, a.in[9], QSCALE, true, (bf16*)(ws + OFF_QN) + ((size_t)tt * 32 * 16 + hd) * 128, 2048, 0}; }
            else if (r < NT_Q + 4 * NT_G) {
                r -= NT_Q;
                const int kind = 2 + r / NT_G, q = r % NT_G, bg = q >> 7, tile = q & 127, b = bg >> 2, g = bg & 3;
                const bf16* src = raw + ((size_t)b * SEQ + tile * 32) * NSA_WP + 2048 + kind * 512 + g * 128;
                const size_t tofs = ((size_t)bg * 128 + tile) * 4096;
                const size_t doff = kind == 2 ? OFF_KFS : kind == 3 ? OFF_VFS : kind == 4 ? OFF_KFW : OFF_VFW;
                const int mode = (kind & 1) ? 2 : 1;
                t = LT{src, (size_t)NSA_WP, a.in[10] + (kind == 2 ? 128 : 256), 1.f, kind == 2 || kind == 4, (bf16*)(ws + doff) + tofs, 128, mode};
            } else { r -= NT_Q + 4 * NT_G; gate_task = true; }
        } else {
            const int kind = r / NT_Q; r = r % NT_Q;
            if (kind == 0) { const int tt = r >> 4, hd = r & 15;
                t = LT{raw + (size_t)tt * 32 * 6144 + hd * 128, 6144, a.in[18], QSCALE, true, (bf16*)(ws + OFF_QN) + ((size_t)tt * 32 * 16 + hd) * 128, 2048, 0}; }
            else { const int bh = r >> 7, tile = r & 127, b = bh >> 4, hd = bh & 15;
                t = LT{raw + ((size_t)b * SEQ + tile * 32) * 6144 + kind * 2048 + hd * 128, 6144, a.in[19], 1.f, kind == 1, (bf16*)(ws + (kind == 1 ? OFF_KF : OFF_VF)) + ((size_t)bh * 128 + tile) * 4096, 128, kind}; }
        }
        if (gate_task) {
            float* gt = (float*)(ws + OFF_GATE);
            for (int i = lane; i < 32 * 48; i += 64) { const int tq = r * 32 + i / 48, c = i % 48; const float v = bf1(raw[(size_t)tq * NSA_WP + 5120 + c]); gt[(size_t)tq * 48 + c] = 1.0f / (1.0f + __expf(-v)); }
        } else run_lt(t, lane, lds + wave * 8704);
    }
}

__device__ __forceinline__ void cmp_gemm1_task(unsigned char* ws, int tk, int lane) {
    const int i = lane & 31, hi = lane >> 5;
    const int kh = tk >> 10, which = (tk >> 9) & 1, mt = (tk >> 3) & 63, nt = tk & 7;
    const int rr = mt * 32 + i, bg = rr >> 8, j = rr & 255, b = bg >> 2, g = bg & 3;
    const bf16* A = (const bf16*)(ws + OFF_RAW) + (size_t)(b * SEQ + 16 * j) * NSA_WP + 2048 + which * 512 + g * 128 + 8 * hi;
    const bf16* Bt = (const bf16*)(ws + OFF_WC1) + (size_t)which * 256 * 2048 + (size_t)(nt * 32 + i) * 2048 + 8 * hi;
    f32x16 acc;
#pragma unroll
    for (int r = 0; r < 16; ++r) acc[r] = 0.f;
    for (int k8 = 8 * kh; k8 < 8 * kh + 8; ++k8) {
        bf16x8 av[8], bv[8];
#pragma unroll
        for (int jj = 0; jj < 8; ++jj) { av[jj] = *(const bf16x8*)(A + (size_t)k8 * NSA_WP + 16 * jj); bv[jj] = *(const bf16x8*)(Bt + 16 * (8 * k8 + jj)); }
        PIN8(av); PIN8(bv);
#pragma unroll
        for (int jj = 0; jj < 8; ++jj) acc = MFMA32(av[jj], bv[jj], acc);
    }
    float* Y = (float*)(ws + OFF_Y) + (size_t)(which * 2 + kh) * 2048 * 256;
#pragma unroll
    for (int r = 0; r < 16; ++r) Y[(size_t)(mt * 32 + crow(r, hi)) * 256 + nt * 32 + i] = acc[r];
}
__device__ __forceinline__ void cmp_stage2(const Args& a, int wave, int lane, int G, int bid) {
    unsigned char* ws = a.ws; const int gw = bid * NWAVES + wave, NGW = G * NWAVES;
    const float* b1 = (const float*)(ws + OFF_BIAS1);
    for (int tk = gw; tk < 2 * 8 * 256; tk += NGW) {
        const int which = tk >> 11, bg = (tk >> 8) & 7, c = tk & 255;
        float o0 = 0.f, o1 = 0.f;
        if (c < 255) {
            const float* Y = (const float*)(ws + OFF_Y) + (size_t)which * 2 * 2048 * 256 + (size_t)(bg * 256 + c) * 256;
            const float* Yh = Y + (size_t)2048 * 256;
            float p0 = (Y[lane] + Yh[lane]) + (Y[256 + 128 + lane] + Yh[256 + 128 + lane]) + b1[which * 128 + lane];
            float p1 = (Y[64 + lane] + Yh[64 + lane]) + (Y[256 + 128 + 64 + lane] + Yh[256 + 128 + 64 + lane]) + b1[which * 128 + 64 + lane];
            const float a0 = p0 / (1.0f + __expf(-p0)), a1 = p1 / (1.0f + __expf(-p1));
            const float* w2 = a.in[13] + (size_t)which * 128 * 128;
            for (int n = 0; n < 64; ++n) {
                const float x0 = __builtin_bit_cast(float, __builtin_amdgcn_readlane(__builtin_bit_cast(int, a0), n));
                const float x1 = __builtin_bit_cast(float, __builtin_amdgcn_readlane(__builtin_bit_cast(int, a1), n));
                o0 += x0 * w2[n * 128 + lane] + x1 * w2[(64 + n) * 128 + lane];
                o1 += x0 * w2[n * 128 + 64 + lane] + x1 * w2[(64 + n) * 128 + 64 + lane];
            }
            if (which == 0) {
                const float ss = wave_sum(o0 * o0 + o1 * o1); const float r = __builtin_amdgcn_rsqf(ss * (1.0f / HD) + EPS);
                o0 *= r * a.in[10][lane]; o1 *= r * a.in[10][64 + lane];
            }
        }
        const int tile = c >> 5, kk = c & 31;
#pragma unroll
        for (int hf = 0; hf < 2; ++hf) {
            const int d = hf * 64 + lane; const bf16 val = (bf16)f2bf(hf ? o1 : o0);
            if (which == 0) { const int d0 = d >> 4, hh = (d >> 3) & 1, e = d & 7;
                ((bf16*)(ws + OFF_KFC))[((size_t)bg * 8 + tile) * 4096 + (size_t)(d0 * 64 + hh * 32 + kk) * 8 + e] = val; }
            else { const int s = kk >> 4, e = ((kk >> 3) & 1) * 4 + (kk & 3), hh = (kk >> 2) & 1, db = d >> 5, dd = d & 31;
                ((bf16*)(ws + OFF_VFC))[((size_t)bg * 8 + tile) * 4096 + (size_t)((s * 4 + db) * 64 + hh * 32 + dd) * 8 + e] = val; }
        }
    }
}

template <class KP>
__device__ __forceinline__ f32x16 qk_tile(KP Kt, const bf16x8 (&qr)[8], int lane) {
    f32x16 p;
#pragma unroll
    for (int r = 0; r < 16; ++r) p[r] = 0.f;
#pragma unroll
    for (int d0 = 0; d0 < 8; ++d0) p = MFMA32(Kt[d0 * 64 + lane], qr[d0], p);
    return p;
}
template <class VP>
__device__ __forceinline__ void pv_tile(VP Vt, const f32x16& p, f32x16 (&o)[4], int lane) {
    u32x4 w0, w1;
    w0.x = cvtpk(p[0], p[1]); w0.y = cvtpk(p[2], p[3]); w0.z = cvtpk(p[4], p[5]); w0.w = cvtpk(p[6], p[7]);
    w1.x = cvtpk(p[8], p[9]); w1.y = cvtpk(p[10], p[11]); w1.z = cvtpk(p[12], p[13]); w1.w = cvtpk(p[14], p[15]);
    const bf16x8 pf0 = __builtin_bit_cast(bf16x8, w0), pf1 = __builtin_bit_cast(bf16x8, w1);
#pragma unroll
    for (int db = 0; db < 4; ++db) { o[db] = MFMA32(Vt[db * 64 + lane], pf0, o[db]); o[db] = MFMA32(Vt[(4 + db) * 64 + lane], pf1, o[db]); }
}
template <class KP, class VP, class VF>
__device__ __forceinline__ void flash_step(KP Kt, VP Vt, const bf16x8 (&qr)[8], f32x16 (&o)[4], float& m, float& l, int lane, VF valid) {
    f32x16 p = qk_tile(Kt, qr, lane);
    __builtin_amdgcn_sched_barrier(0);
    const int hi = lane >> 5;
    float mx = NEGF;
#pragma unroll
    for (int r = 0; r < 16; ++r) { const bool v = valid(crow(r, hi)); p[r] = v ? p[r] : NEGF; mx = fmaxf(mx, p[r]); }
    mx = fmaxf(mx, __shfl_xor(mx, 32));
    const float mn = fmaxf(m, mx);
    const float alpha = ex2(m - mn);
    m = mn;
    float ls = 0.f;
#pragma unroll
    for (int r = 0; r < 16; ++r) { const float e = (p[r] > -1e29f) ? ex2(p[r] - mn) : 0.f; p[r] = e; ls += e; }
    l = l * alpha + ls;
    if (__any(alpha != 1.0f)) {
#pragma unroll
        for (int db = 0; db < 4; ++db)
#pragma unroll
            for (int r = 0; r < 16; ++r) o[db][r] *= alpha;
    }
    pv_tile(Vt, p, o, lane);
}
template <class VF>
__device__ __forceinline__ void flash_step_lds(const LAS bf16x8* Kt, const LAS bf16x8* Vt, const bf16x8 (&qr)[8], f32x16 (&o)[4], float& m, float& l, int lane, bool rowok, bool need_elem, VF valid) {
    bf16x8 kf[8], vf[8];
#pragma unroll
    for (int d0 = 0; d0 < 8; ++d0) kf[d0] = Kt[d0 * 64 + lane];
    PIN8(kf);
    f32x16 p;
#pragma unroll
    for (int r = 0; r < 16; ++r) p[r] = 0.f;
    __builtin_amdgcn_s_setprio(1);
#pragma unroll
    for (int d0 = 0; d0 < 8; ++d0) p = MFMA32(kf[d0], qr[d0], p);
    __builtin_amdgcn_s_setprio(0);
    __builtin_amdgcn_sched_barrier(0);
#pragma unroll
    for (int i = 0; i < 8; ++i) vf[i] = Vt[i * 64 + lane];
    __builtin_amdgcn_sched_barrier(0);
    const int hi = lane >> 5;
    float mx = NEGF;
    if (need_elem) {
#pragma unroll
        for (int r = 0; r < 16; ++r) { const bool v = rowok && valid(crow(r, hi)); p[r] = v ? p[r] : NEGF; mx = fmaxf(mx, p[r]); }
    } else {
#pragma unroll
        for (int r = 0; r < 16; ++r) { p[r] = rowok ? p[r] : NEGF; mx = fmaxf(mx, p[r]); }
    }
    mx = fmaxf(mx, __shfl_xor(mx, 32));
    if (__any(mx > m + 8.0f)) {
        const float mn = fmaxf(m, mx);
        const float alpha = ex2(m - mn);
        m = mn; l *= alpha;
#pragma unroll
        for (int db = 0; db < 4; ++db)
#pragma unroll
            for (int r = 0; r < 16; ++r) o[db][r] *= alpha;
    }
    float ls = 0.f;
    if (need_elem) {
#pragma unroll
        for (int r = 0; r < 16; ++r) { const float e = (p[r] > -1e29f) ? ex2(p[r] - m) : 0.f; p[r] = e; ls += e; }
    } else {
#pragma unroll
        for (int r = 0; r < 16; ++r) { const float e = ex2(p[r] - m); p[r] = e; ls += e; }
    }
    l += ls;
    u32x4 w0, w1;
    w0.x = cvtpk(p[0], p[1]); w0.y = cvtpk(p[2], p[3]); w0.z = cvtpk(p[4], p[5]); w0.w = cvtpk(p[6], p[7]);
    w1.x = cvtpk(p[8], p[9]); w1.y = cvtpk(p[10], p[11]); w1.z = cvtpk(p[12], p[13]); w1.w = cvtpk(p[14], p[15]);
    const bf16x8 pf0 = __builtin_bit_cast(bf16x8, w0), pf1 = __builtin_bit_cast(bf16x8, w1);
#pragma unroll
    for (int db = 0; db < 4; ++db) { o[db] = MFMA32(vf[db], pf0, o[db]); o[db] = MFMA32(vf[4 + db], pf1, o[db]); }
}
__device__ __forceinline__ void zero_o(f32x16 (&o)[4]) {
#pragma unroll
    for (int db = 0; db < 4; ++db)
#pragma unroll
        for (int r = 0; r < 16; ++r) o[db][r] = 0.f;
}
__device__ __forceinline__ void store_o(const f32x16 (&o)[4], bf16* orow  , int hi) {
#pragma unroll
    for (int db = 0; db < 4; ++db)
#pragma unroll
        for (int gq = 0; gq < 4; ++gq) { u32x2 w; w.x = cvtpk(o[db][4 * gq], o[db][4 * gq + 1]); w.y = cvtpk(o[db][4 * gq + 2], o[db][4 * gq + 3]);
            *(u32x2*)(orow + 32 * db + 8 * gq + 4 * hi) = w; }
}

constexpr size_t OFF_OST2 = OFF_RAW;
constexpr size_t OFF_OST = OFF_H, OFF_SELM = OFF_H + 64 * MiB, OFF_UM = OFF_SELM + 512 * 1024;
__device__ __forceinline__ void nsa_unit(int pp, int half, int& bg, int& tb) { bg = pp & 7; tb = half ? 63 - (pp >> 3) : (pp >> 3); }
__device__ __forceinline__ void load_q(bf16x8 (&qr)[8], const unsigned char* ws, int row, int head, int hi) {
    const bf16* qp = (const bf16*)(ws + OFF_QN) + ((size_t)row * 16 + head) * 128 + 8 * hi;
#pragma unroll
    for (int d0 = 0; d0 < 8; ++d0) qr[d0] = *(const bf16x8*)(qp + 16 * d0);
}
template <class F>
__device__ __forceinline__ void ring_sweep(LAS unsigned char* ring, const unsigned char* Kb, const unsigned char* Vb, unsigned toff, int wave, int Tfirst, int Tmax, unsigned long long um, F f) {
#define RS_NEXT(Tc) ({ int Tn_ = (Tc) + 1; while (Tn_ <= Tmax && !((um >> (Tn_ >> 1)) & 1ull)) ++Tn_; Tn_; })
#define RS_DMA(Tt, slot) do { LAS unsigned char* d_ = ring + (slot) * 16384 + wave * 1024; \
        __builtin_amdgcn_global_load_lds((const unsigned*)(Kb + (unsigned)(Tt) * 8192u + toff), (LAS unsigned*)d_, 16, 0, 0); \
        __builtin_amdgcn_global_load_lds((const unsigned*)(Vb + (unsigned)(Tt) * 8192u + toff), (LAS unsigned*)(d_ + 8192), 16, 0, 0); } while (0)
    __builtin_amdgcn_s_barrier();
    int Ta = Tfirst, Tb = Ta <= Tmax ? RS_NEXT(Ta) : Tmax + 1, Tc = Tb <= Tmax ? RS_NEXT(Tb) : Tmax + 1, slot = 0;
    if (Ta <= Tmax) RS_DMA(Ta, 0);
    if (Tb <= Tmax) RS_DMA(Tb, 1);
    if (Tc <= Tmax) RS_DMA(Tc, 2);
    while (Ta <= Tmax) {
        if (Tc <= Tmax) asm volatile("s_waitcnt vmcnt(4)" ::: "memory");
        else if (Tb <= Tmax) asm volatile("s_waitcnt vmcnt(2)" ::: "memory");
        else asm volatile("s_waitcnt vmcnt(0)" ::: "memory");
        __builtin_amdgcn_s_barrier();
        __builtin_amdgcn_sched_barrier(0);
        const int Td = Tc <= Tmax ? RS_NEXT(Tc) : Tmax + 1;
        if (Td <= Tmax) RS_DMA(Td, (slot + 3) & 3);
        LAS unsigned char* tp = ring + slot * 16384;
        f(Ta, (const LAS bf16x8*)tp, (const LAS bf16x8*)(tp + 8192));
        Ta = Tb; Tb = Tc; Tc = Td; slot = (slot + 1) & 3;
    }
#undef RS_NEXT
#undef RS_DMA
}
__device__ __forceinline__ void nsa_cmp(const Args& a, LAS unsigned char* lds, int wave, int lane, int G, int bid, int tid) {
    unsigned char* ws = a.ws;
    LAS float* impH = (LAS float*)(lds + 65536);
    LAS unsigned long long* ump = (LAS unsigned long long*)(lds + 131072);
    const int q = lane & 31, hi = lane >> 5, h = wave & 3, sub = wave >> 2;
    const float* gates = (const float*)(ws + OFF_GATE);
    const unsigned toff = (unsigned)tid * 16u;
    for (int pp = bid; pp < 256; pp += G)
        for (int half = 0; half < 2; ++half) {
            int bg, tb; nsa_unit(pp, half, bg, tb);
            const int b = bg >> 2, g = bg & 3, unit = bg * 64 + tb;
            const int t0 = tb * 64 + sub * 32, t = t0 + q, row = b * SEQ + t, head = g * 4 + h;
            bf16x8 qr[8]; load_q(qr, ws, row, head, hi);
            f32x16 o[4];
            const unsigned char* Kb = ws + OFF_KFC + (size_t)bg * 8 * 8192;
            const unsigned char* Vb = ws + OFF_VFC + (size_t)bg * 8 * 8192;
            const int nTc = (t0 >> 9) + 1;
            float m = NEGF, l = 0.f;
            zero_o(o);
            ring_sweep(lds, Kb, Vb, toff, wave, 0, nTc - 1, ~0ull, [&](int T, const LAS bf16x8* Kt, const LAS bf16x8* Vt) {
                flash_step_lds(Kt, Vt, qr, o, m, l, lane, true, T >= nTc - 2, [=](int kk) { return 16 * (32 * T + kk) + 31 <= t; }); });
            const float lt = l + __shfl_xor(l, 32);
            {
                unsigned* ostw = (unsigned*)(ws + OFF_OST) + (size_t)(unit * NWAVES + wave) * 2048;
                const float inv = lt > 0.f ? gates[(unsigned)(row * 48 + head * 3 + 0)] / lt : 0.f;
#pragma unroll
                for (int db = 0; db < 4; ++db)
#pragma unroll
                    for (int r = 0; r < 16; r += 2) ostw[(unsigned)((db * 8 + (r >> 1)) * 64 + lane)] = cvtpk(o[db][r] * inv, o[db][r + 1] * inv);
            }
            {
                const float invl = lt > 0.f ? 1.0f / lt : 0.f;
                float prevB = 0.f;
                LAS float* dst = impH + ((sub * 4 + h) * 32 + q) * 64;
                ring_sweep(lds, Kb, Vb, toff, wave, 0, nTc - 1, ~0ull, [&](int T, const LAS bf16x8* Kt, const LAS bf16x8* Vt) {
                    f32x16 p = qk_tile(Kt, qr, lane);
#pragma unroll
                    for (int r = 0; r < 16; ++r) { const bool v = 16 * (32 * T + crow(r, hi)) + 31 <= t; p[r] = v ? ex2(p[r] - m) * invl : 0.f; }
                    float Bp[4];
#pragma unroll
                    for (int gg = 0; gg < 4; ++gg) Bp[gg] = __shfl_xor(p[4 * gg + 3], 32);
#pragma unroll
                    for (int gg = 0; gg < 4; ++gg) {
                        const float A = (p[4 * gg] + p[4 * gg + 1]) + (p[4 * gg + 2] + p[4 * gg + 3]);
                        const float Bv = hi ? Bp[gg] : (gg ? Bp[gg ? gg - 1 : 0] : prevB);
                        dst[8 * T + 2 * gg + hi] = A + Bv;
                    }
                    prevB = Bp[3];
                });
            }
            __syncthreads();
            {
                unsigned long long wm = 0ull;
                unsigned long long* selm = (unsigned long long*)(ws + OFF_SELM) + (size_t)unit * 64;
                for (int jj = 0; jj < 8; ++jj) {
                    const int j = wave * 8 + jj, sj = j >> 5, qj = j & 31, s = lane, cur = tb;
                    float v = 0.f;
                    if (s <= tb) { const LAS float* src = impH + (sj * 4 * 32 + qj) * 64 + s; v = (src[0] + src[32 * 64]) + (src[2 * 32 * 64] + src[3 * 32 * 64]); }
                    const bool valid = s <= cur, forced = (s == 0) || (s == cur) || (s == cur - 1);
                    const float val = forced ? 1e4f : (valid ? v : -1e4f);
                    int rank = 0;
                    for (int jx = 0; jx < 64; ++jx) { const float ov = __builtin_bit_cast(float, __builtin_amdgcn_readlane(__builtin_bit_cast(int, val), jx)); rank += ((ov > val) || (ov == val && jx < lane)) ? 1 : 0; }
                    const unsigned long long mk = __ballot(rank < 16 && valid);
                    if (lane == 0) selm[j] = mk;
                    wm |= mk;
                }
                if (lane == 0) ump[wave] = wm;
            }
            __syncthreads();
            if (wave == 0 && lane == 0) { unsigned long long um = 0ull;
#pragma unroll
                for (int w8 = 0; w8 < 8; ++w8) um |= ump[w8];
                ((unsigned long long*)(ws + OFF_UM))[unit] = um; }
        }
}
template <bool WIN>
__device__ __forceinline__ void nsa_sweep(const Args& a, LAS unsigned char* lds, int wave, int lane, int G, int bid, int tid) {
    unsigned char* ws = a.ws;
    const int q = lane & 31, hi = lane >> 5, h = wave & 3, sub = wave >> 2;
    const float* gates = (const float*)(ws + OFF_GATE);
    const unsigned toff = (unsigned)tid * 16u;
    for (int pp = bid; pp < 256; pp += G)
        for (int half = 0; half < 2; ++half) {
            int bg, tb; nsa_unit(pp, half, bg, tb);
            const int b = bg >> 2, g = bg & 3, unit = bg * 64 + tb;
            const int t0 = tb * 64 + sub * 32, t = t0 + q, row = b * SEQ + t, head = g * 4 + h;
            bf16x8 qr[8]; load_q(qr, ws, row, head, hi);
            unsigned long long msk = ~0ull, um = ~0ull;
            if (!WIN) { msk = ((const unsigned long long*)(ws + OFF_SELM))[(unsigned)(unit * 64 + sub * 32 + q)]; um = ((const unsigned long long*)(ws + OFF_UM))[unit]; }
            const unsigned char* Kb = ws + (WIN ? OFF_KFW : OFF_KFS) + (size_t)bg * 128 * 8192;
            const unsigned char* Vb = ws + (WIN ? OFF_VFW : OFF_VFS) + (size_t)bg * 128 * 8192;
            f32x16 o[4]; zero_o(o);
            float m = NEGF, l = 0.f;
            const int Tmax = 2 * tb + 1;
            const int Tfirst = WIN ? (2 * tb >= 16 ? 2 * tb - 16 : 0) : 0;
            ring_sweep(lds, Kb, Vb, toff, wave, Tfirst, Tmax, um, [&](int T, const LAS bf16x8* Kt, const LAS bf16x8* Vt) {
                const int Td = t0 >> 5;
                if (WIN) flash_step_lds(Kt, Vt, qr, o, m, l, lane, true, (T >= Td) || (T <= Td - 16), [=](int kk) { const int key = 32 * T + kk; return key <= t && t - key < 512; });
                else { const bool bit = (msk >> (T >> 1)) & 1ull;
                    flash_step_lds(Kt, Vt, qr, o, m, l, lane, bit, T >= Td, [=](int kk) { return 32 * T + kk <= t; }); } });
            const float lt = l + __shfl_xor(l, 32);
            const float inv = lt > 0.f ? gates[(unsigned)(row * 48 + head * 3 + (WIN ? 2 : 1))] / lt : 0.f;
            const unsigned* osrc = (const unsigned*)(ws + (WIN ? OFF_OST2 : OFF_OST)) + (size_t)(unit * NWAVES + wave) * 2048;
            int lane2 = lane; asm volatile("" : "+v"(lane2));
            unsigned* ostw = (unsigned*)(ws + OFF_OST2) + (size_t)(unit * NWAVES + wave) * 2048;
#pragma unroll
            for (int db = 0; db < 4; ++db) {
#pragma unroll
                for (int r = 0; r < 16; r += 2) { const unsigned w = osrc[(unsigned)((db * 8 + (r >> 1)) * 64 + lane2)]; o[db][r] = bflo(w) + o[db][r] * inv; o[db][r + 1] = bfhi(w) + o[db][r + 1] * inv; }
                __builtin_amdgcn_sched_barrier(0); }
            if (WIN) store_o(o, (bf16*)(ws + OFF_Z) + (unsigned)(row * D + head * 128), hi);
            else {
#pragma unroll
                for (int db = 0; db < 4; ++db)
#pragma unroll
                    for (int r = 0; r < 16; r += 2) ostw[(unsigned)((db * 8 + (r >> 1)) * 64 + lane)] = cvtpk(o[db][r], o[db][r + 1]);
            }
        }
}

__device__ __forceinline__ void sb_core(const Args& a, int wave, int lane, int G, int bid) {
    unsigned char* ws = a.ws;
    const int q = lane & 31, hi = lane >> 5;
    for (int u = bid; u < 512; u += G) {
        const int bh = u >> 4, tb = u & 15, b = bh >> 4, head = bh & 15;
        const int t0 = tb * 256 + wave * 32, t = t0 + q, row = b * SEQ + t;
        bf16x8 qr[8];
        { const bf16* qp = (const bf16*)(ws + OFF_QN) + ((size_t)row * 16 + head) * 128 + 8 * hi;
#pragma unroll
          for (int d0 = 0; d0 < 8; ++d0) qr[d0] = *(const bf16x8*)(qp + 16 * d0); }
        const bf16x8* Kb = (const bf16x8*)(ws + OFF_KF) + (size_t)bh * 128 * 512;
        const bf16x8* Vb = (const bf16x8*)(ws + OFF_VF) + (size_t)bh * 128 * 512;
        f32x16 o[4]; zero_o(o);
        float carry = 1.0f;
        bf16x8 kf[8];
#pragma unroll
        for (int d0 = 0; d0 < 8; ++d0) kf[d0] = Kb[(size_t)(t0 >> 5) * 512 + d0 * 64 + lane];
        for (int T = t0 >> 5; T >= 0; --T) {
            bf16x8 vf[8];
            PIN8(kf);
#pragma unroll
            for (int i = 0; i < 8; ++i) vf[i] = Vb[(size_t)T * 512 + i * 64 + lane];
            f32x16 p;
#pragma unroll
            for (int r = 0; r < 16; ++r) p[r] = 0.f;
#pragma unroll
            for (int d0 = 0; d0 < 8; ++d0) p = MFMA32(kf[d0], qr[d0], p);
            __builtin_amdgcn_sched_barrier(0);
            {
                const int Tn = T > 0 ? T - 1 : 0;
#pragma unroll
                for (int d0 = 0; d0 < 8; ++d0) kf[d0] = Kb[(size_t)Tn * 512 + d0 * 64 + lane];
            }
            __builtin_amdgcn_sched_barrier(0);
            float rv[16];
#pragma unroll
            for (int r = 0; r < 16; ++r) {
                const int key = 32 * T + crow(r, hi);
                const float e = ex2(fminf(p[r], 80.f)); const float rr = __builtin_amdgcn_rcpf(1.0f + e);
                const bool ok = key < t;
                rv[r] = ok ? rr : 1.0f; p[r] = ok ? e * rr : 0.f;
            }
            float Gp[4], Tt[4];
#pragma unroll
            for (int gg = 0; gg < 4; ++gg) { const float Gm = (rv[4 * gg] * rv[4 * gg + 1]) * (rv[4 * gg + 2] * rv[4 * gg + 3]); Gp[gg] = __shfl_xor(Gm, 32); Tt[gg] = Gm * Gp[gg]; }
            float suf = carry;
#pragma unroll
            for (int gg = 3; gg >= 0; --gg) {
                float w = suf * (hi ? 1.0f : Gp[gg]);
                p[4 * gg + 3] *= w; w *= rv[4 * gg + 3];
                p[4 * gg + 2] *= w; w *= rv[4 * gg + 2];
                p[4 * gg + 1] *= w; w *= rv[4 * gg + 1];
                p[4 * gg] *= w;
                suf *= Tt[gg];
            }
            carry = suf;
            {
                u32x4 w0, w1;
                w0.x = cvtpk(p[0], p[1]); w0.y = cvtpk(p[2], p[3]); w0.z = cvtpk(p[4], p[5]); w0.w = cvtpk(p[6], p[7]);
                w1.x = cvtpk(p[8], p[9]); w1.y = cvtpk(p[10], p[11]); w1.z = cvtpk(p[12], p[13]); w1.w = cvtpk(p[14], p[15]);
                const bf16x8 pf0 = __builtin_bit_cast(bf16x8, w0), pf1 = __builtin_bit_cast(bf16x8, w1);
#pragma unroll
                for (int db = 0; db < 4; ++db) { o[db] = MFMA32(vf[db], pf0, o[db]); o[db] = MFMA32(vf[4 + db], pf1, o[db]); }
            }
            if (!__any(carry > 1e-37f)) break;
        }
        store_o(o, (bf16*)(ws + OFF_Z) + (size_t)row * D + head * 128, hi);
    }
}


#define XB_TMO      128
#define XB_XCNT(j)  (256  + 64 * (j))
#define XB_XSUB(j)  (1280 + 64 * (j))
#define XB_XGEN(j)  (2304 + 64 * (j))
#define XB_TOP      3328
#define XB_TOPGEN   3392
#define XCD_BAR_WORDS 3456
#define XB_SPIN_CAP (1u << 20)
__device__ __forceinline__ unsigned xb_ld(unsigned* p)              { return __hip_atomic_load(p, __ATOMIC_RELAXED, __HIP_MEMORY_SCOPE_AGENT); }
__device__ __forceinline__ unsigned xb_add(unsigned* p, unsigned v) { return __hip_atomic_fetch_add(p, v, __ATOMIC_RELAXED, __HIP_MEMORY_SCOPE_AGENT); }
__device__ __forceinline__ unsigned xb_xcc_id() { return (unsigned)__builtin_amdgcn_s_getreg((3 << 11) | 20) & 0xFu; }
#define XB_SPIN(cond, bar) do { unsigned _sp = 0; while (cond) { \
    if ((++_sp & 255u) == 0u) { if (xb_ld(&(bar)[XB_TMO])) break; if (_sp > XB_SPIN_CAP) { atomicAdd(&(bar)[XB_TMO], 1u); break; } } } } while (0)
struct XcdBarrier { unsigned* bar; unsigned x; volatile LAS unsigned* st; };
__device__ __forceinline__ XcdBarrier xcd_barrier_post(unsigned* bar, volatile LAS unsigned* st) {
    XcdBarrier b; b.bar = bar; b.x = xb_xcc_id(); b.st = st;
    if (threadIdx.x == 0) (void)xb_add(&bar[XB_XCNT(b.x)], 1u);
    return b;
}
__device__ __forceinline__ void xcd_barrier_complete(unsigned* bar, unsigned x, unsigned& nloc, unsigned& nx) {
    const unsigned G = gridDim.x * gridDim.y * gridDim.z;
    unsigned sum, cnt, mine, sp = 0u;
    for (;;) {
        sum = 0u; cnt = 0u; mine = 0u;
#pragma unroll
        for (unsigned j = 0; j < 16; ++j) { const unsigned c = xb_ld(&bar[XB_XCNT(j)]); sum += c; cnt += (c > 0u) ? 1u : 0u; mine = (j == x) ? c : mine; }
        if (sum == G) break;
        __builtin_amdgcn_s_sleep(1);
        if ((++sp & 255u) == 0u) { if (xb_ld(&bar[XB_TMO])) break; if (sp > XB_SPIN_CAP) { atomicAdd(&bar[XB_TMO], 1u); break; } }
    }
    nloc = mine > 0u ? mine : 1u; nx = cnt > 0u ? cnt : 1u;
}
__device__ __forceinline__ void xcd_barrier(const XcdBarrier& b) {
    asm volatile("s_waitcnt vmcnt(0)" ::: "memory");
    __syncthreads();
    if (threadIdx.x == 0) {
        unsigned* bar = b.bar;
        __builtin_amdgcn_s_waitcnt(0);
        unsigned nloc = b.st[0], nx = b.st[1];
        if (nloc == 0u) { xcd_barrier_complete(bar, b.x, nloc, nx); b.st[0] = nloc; b.st[1] = nx; }
        const unsigned old = xb_add(&bar[XB_XSUB(b.x)], 1u);
        const unsigned gen = old / nloc;
        if (old + 1u == (gen + 1u) * nloc) {
            __builtin_amdgcn_fence(__ATOMIC_RELEASE, "agent");
            asm volatile("s_waitcnt vmcnt(0)" ::: "memory");
            const unsigned og = xb_add(&bar[XB_TOP], 1u);
            const unsigned tg = og / nx;
            if (og + 1u == (tg + 1u) * nx) xb_add(&bar[XB_TOPGEN], 1u);
            else XB_SPIN(xb_ld(&bar[XB_TOPGEN]) == tg, bar);
            __builtin_amdgcn_fence(__ATOMIC_ACQUIRE, "agent");
            xb_add(&bar[XB_XGEN(b.x)], 1u);
            asm volatile("s_waitcnt vmcnt(0)" ::: "memory");
        } else {
            XB_SPIN(xb_ld(&bar[XB_XGEN(b.x)]) == gen, bar);
            __builtin_amdgcn_fence(__ATOMIC_ACQUIRE, "agent");
            asm volatile("s_waitcnt vmcnt(0)" ::: "memory");
        }
    }
    __syncthreads();
}

__device__ __forceinline__ bool gemm_desc(int ph, const Args& a, pg8::Gemm& g, pg8::Epi& E) {
    unsigned char* ws = a.ws;
    bf16* xb = (bf16*)(ws + OFF_XB); bf16* hb = (bf16*)(ws + OFF_H); bf16* raw = (bf16*)(ws + OFF_RAW); bf16* z = (bf16*)(ws + OFF_Z);
    float* ssq = (float*)(ws + OFF_SSQ);
    auto act = [&](const bf16* A, const bf16* Bt, int N, int K, bf16* O, int ldc, const float* sq, int mode) {
        g = pg8::Gemm{A, Bt, M, N, K, K, K, 0}; E = pg8::Epi{mode, O, ldc, sq, nullptr, nullptr, nullptr}; };
    auto res = [&](const bf16* A, const bf16* Bt, int K, int lda, int ldb, int agrp, const float* xin, float* sq_out) {
        g = pg8::Gemm{A, Bt, M, D, K, lda, ldb, agrp}; E = pg8::Epi{2, xb, D, nullptr, xin, ph == 25 ? a.out : nullptr, sq_out}; };
    switch (ph) {
        case 1: act(xb, (const bf16*)(ws + OFF_CIN), 6144, D, raw, 6144, ssq + 0 * SSQ_STRIDE, 0); return true;
        case 3: res(z, (const bf16*)(ws + OFF_COUT), D, D, D, 0, a.in[0], ssq + 1 * SSQ_STRIDE); return true;
        case 4: act(xb, (const bf16*)(ws + OFF_W1T), FF, D, hb, FF, ssq + 1 * SSQ_STRIDE, 1); return true;
        case 5: res(hb, (const bf16*)(ws + OFF_W2T), FF, FF, FF, 0, a.out, ssq + 2 * SSQ_STRIDE); return true;
        case 6: act(xb, (const bf16*)(ws + OFF_NIN), NSA_WP, D, raw, NSA_WP, ssq + 2 * SSQ_STRIDE, 0); return true;
        case 13: res(z, (const bf16*)(ws + OFF_NOUT), D, D, D, 0, a.out, ssq + 3 * SSQ_STRIDE); return true;
        case 14: act(xb, (const bf16*)(ws + OFF_W1T) + (size_t)1 * D * FF, FF, D, hb, FF, ssq + 3 * SSQ_STRIDE, 1); return true;
        case 15: res(hb, (const bf16*)(ws + OFF_W2T) + (size_t)1 * D * FF, FF, FF, FF, 0, a.out, ssq + 4 * SSQ_STRIDE); return true;
        case 17: res(z, (const bf16*)(ws + OFF_POOL), 512, D, 512, 1, a.out, ssq + 5 * SSQ_STRIDE); return true;
        case 18: act(xb, (const bf16*)(ws + OFF_W1T) + (size_t)2 * D * FF, FF, D, hb, FF, ssq + 5 * SSQ_STRIDE, 1); return true;
        case 19: res(hb, (const bf16*)(ws + OFF_W2T) + (size_t)2 * D * FF, FF, FF, FF, 0, a.out, ssq + 6 * SSQ_STRIDE); return true;
        case 20: act(xb, (const bf16*)(ws + OFF_SIN), 6144, D, raw, 6144, ssq + 6 * SSQ_STRIDE, 0); return true;
        case 23: res(z, (const bf16*)(ws + OFF_SOUT), D, D, D, 0, a.out, ssq + 7 * SSQ_STRIDE); return true;
        case 24: act(xb, (const bf16*)(ws + OFF_W1T) + (size_t)3 * D * FF, FF, D, hb, FF, ssq + 7 * SSQ_STRIDE, 1); return true;
        case 25: res(hb, (const bf16*)(ws + OFF_W2T) + (size_t)3 * D * FF, FF, FF, FF, 0, a.out, ssq + 8 * SSQ_STRIDE); return true;
        default: return false;
    }
}

__global__ void __launch_bounds__(NTHREADS, 2) fwd_kernel(Args arg) {
    extern __shared__ __attribute__((aligned(16))) unsigned char lds_raw[];
    LAS unsigned char* lds = (LAS unsigned char*)lds_raw;
    typedef const volatile __attribute__((address_space(4))) unsigned long long* kvptr;
    const int ph_lo = arg.ph_lo, ph_hi = arg.ph_hi;
    volatile LAS unsigned* bst = (volatile LAS unsigned*)(lds + LDS_BYTES - 64);
    if (threadIdx.x < 2) bst[threadIdx.x] = 0u;
    __syncthreads();
    XcdBarrier xbar = xcd_barrier_post((unsigned*)(arg.ws + OFF_CTL), bst);
    for (int pi = ph_lo; pi < ph_hi; ++pi) {
        int ph = 0; if (DUPMASK) { int c = pi; for (;;) { const int reps = ((DUPMASK >> ph) & 1ull) ? 2 : 1; if (c < reps) break; c -= reps; ++ph; } } else ph = pi;
        if (ph == 8) continue;
        Args a;
        { kvptr kp = (kvptr)__builtin_amdgcn_kernarg_segment_ptr();
#pragma unroll
          for (int i = 0; i < 21; ++i) a.in[i] = (const float*)(const __attribute__((address_space(1))) float*)(uintptr_t)kp[i];
          a.out = (float*)(__attribute__((address_space(1))) float*)(uintptr_t)kp[21]; a.ws = (unsigned char*)(__attribute__((address_space(1))) unsigned char*)(uintptr_t)kp[22]; a.ph_lo = ph_lo; a.ph_hi = ph_hi; }
        unsigned char* ws = a.ws;
        int tid = threadIdx.x, G = gridDim.x, bid = blockIdx.x;
        asm volatile("" : "+v"(tid)); asm volatile("" : "+s"(G)); asm volatile("" : "+s"(bid));
        const int lane = tid & 63, wave = __builtin_amdgcn_readfirstlane(tid >> 6);
        pg8::Gemm g; pg8::Epi E;
        if (gemm_desc(ph, a, g, E)) {
            if (PH_EN(100)) {
            pg8::StaticOrder S; S.init(g.M, g.N, G, bid);
            pg8::gemm_phase<true>(lds, g, S, E, tid); }
        } else {
            switch (ph) {
                case 0: if (PH_EN(0)) prologue(a, lds, wave, lane, G, bid); break;
                case 2: if (PH_EN(2)) conv_phase((const bf16*)(ws + OFF_RAW), a.in[6], (bf16*)(ws + OFF_Z), G, tid, bid); break;
                case 7: case 21: if (PH_EN(7)) prep_phase(a, lds, wave, lane, G, bid, ph == 7); break;
                case 9: if (PH_EN(9)) cmp_stage2(a, wave, lane, G, bid); break;
                case 10: if (PH_EN(10)) nsa_cmp(a, lds, wave, lane, G, bid, tid); break;
                case 11: if (PH_EN(11)) nsa_sweep<false>(a, lds, wave, lane, G, bid, tid); break;
                case 12: if (PH_EN(12)) nsa_sweep<true>(a, lds, wave, lane, G, bid, tid); break;
                case 16: if (PH_EN(14)) pool_phase((const bf16*)(ws + OFF_XB), (const float*)(ws + OFF_SSQ) + 4 * SSQ_STRIDE, a.in[1] + 2 * D, (bf16*)(ws + OFF_Z), (LAS float*)lds, G, tid, bid); break;
                case 22: if (PH_EN(20)) sb_core(a, wave, lane, G, bid); break;
                default: break;
            }
        }
        if (pi + 1 < ph_hi) {
            if (ph_hi > 4096) { __syncthreads(); cg::this_grid().sync(); }
            else xcd_barrier(xbar);
        }
    }
}

extern "C" void kernel_launch(void* const* d_in, const int* in_sizes, int n_in, void* d_out, int out_size, void* d_ws, size_t ws_size, hipStream_t stream) {
    static int grid = 0;
    if (grid == 0) {
        if (n_in != 21 || out_size != M * D || ws_size < WS_END) { fprintf(stderr, "kernel_launch: unexpected shapes (n_in %d out %d ws %zu need %zu)\n", n_in, out_size, ws_size, (size_t)WS_END); grid = -1; return; }
        int dev = 0, cus = 0, per_cu = 0;
        hipGetDevice(&dev);
        hipDeviceGetAttribute(&cus, hipDeviceAttributeMultiprocessorCount, dev);
        if (hipFuncSetAttribute((const void*)fwd_kernel, hipFuncAttributeMaxDynamicSharedMemorySize, LDS_BYTES) != hipSuccess) { fprintf(stderr, "kernel_launch: hipFuncSetAttribute failed\n"); grid = -1; return; }
        if (hipOccupancyMaxActiveBlocksPerMultiprocessor(&per_cu, (const void*)fwd_kernel, NTHREADS, LDS_BYTES) != hipSuccess || per_cu < 1) { fprintf(stderr, "kernel_launch: occupancy query says %d\n", per_cu); per_cu = 1; }
        (void)hipGetLastError();
        grid = cus * 1;
        fprintf(stderr, "kernel_launch: cus %d per_cu %d grid %d\n", cus, per_cu, grid);
    }
    if (grid < 0) return;
    Args a{};
    for (int i = 0; i < 21; ++i) a.in[i] = (const float*)d_in[i];
    a.out = (float*)d_out; a.ws = (unsigned char*)d_ws;
    (void)hipMemsetAsync((char*)d_ws + OFF_CTL, 0, 65536, stream);
#if MK_MULTI
    for (int ph = 0; ph < NPH; ++ph) { a.ph_lo = ph; a.ph_hi = ph + 1; hipLaunchKernelGGL(fwd_kernel, dim3(grid), dim3(NTHREADS), LDS_BYTES, stream, a); }
#else
    a.ph_lo = 0; a.ph_hi = NPH + __builtin_popcountll(DUPMASK);
    void* args[] = {&a};
    hipError_t e = hipLaunchCooperativeKernel((const void*)fwd_kernel, dim3(grid), dim3(NTHREADS), args, LDS_BYTES, stream);
    if (e != hipSuccess) fprintf(stderr, "cooperative launch failed: %s (grid %d)\n", hipGetErrorString(e), grid);
#endif
}
```

```cpp
#include <hip/hip_runtime.h>
#include <hip/hip_cooperative_groups.h>
#include <cstdio>
#include <cstdint>
namespace cg = cooperative_groups;

#ifndef MK_MULTI
#define MK_MULTI 0
#endif

#ifndef DUPMASK
#define DUPMASK 0ull
#endif
#ifndef TEST_PH
#define TEST_PH -1
#endif
#define PH_EN(n) (TEST_PH < 0 || TEST_PH == (n))
#define LAS __attribute__((address_space(3)))
typedef unsigned short bf16;
typedef short bf16x8 __attribute__((ext_vector_type(8)));
typedef float f32x4 __attribute__((ext_vector_type(4)));
typedef float f32x16 __attribute__((ext_vector_type(16)));
typedef unsigned u32x4 __attribute__((ext_vector_type(4)));
typedef unsigned u32x2 __attribute__((ext_vector_type(2)));

constexpr int BATCH = 2, SEQ = 4096, D = 2048, M = BATCH * SEQ, FF = 8192, NH = 16, HD = 128;
constexpr int NSA_W = 5168, NSA_WP = 5376;
constexpr float EPS = 1e-6f;
constexpr float NEGF = -1e30f;
constexpr float QSCALE = 0.08838834764831845f * 1.4426950408889634f;

constexpr size_t MiB = 1u << 20;
constexpr size_t OFF_SSQ = 1024ull * 1024 * 738;
constexpr size_t OFF_CTL = 0;
constexpr size_t OFF_BIAS1 = 512 * 1024, OFF_BIAS1P = 512 * 1024 + 4096;
constexpr size_t OFF_W1T = 1 * MiB;
constexpr size_t OFF_W2T = OFF_W1T + 128 * MiB;
constexpr size_t OFF_CIN = OFF_W2T + 128 * MiB;
constexpr size_t OFF_COUT = OFF_CIN + 24 * MiB;
constexpr size_t OFF_NIN = OFF_COUT + 8 * MiB;
constexpr size_t OFF_NOUT = OFF_NIN + 21 * MiB;
constexpr size_t OFF_POOL = OFF_NOUT + 8 * MiB;
constexpr size_t OFF_SIN = OFF_POOL + 2 * MiB;
constexpr size_t OFF_SOUT = OFF_SIN + 24 * MiB;
constexpr size_t OFF_WC1 = OFF_SOUT + 8 * MiB;
constexpr size_t OFF_XB = OFF_WC1 + 2 * MiB;
constexpr size_t OFF_H = OFF_XB + 32 * MiB;
constexpr size_t OFF_RAW = OFF_H + 128 * MiB;
constexpr size_t OFF_Z = OFF_RAW + 96 * MiB;
constexpr size_t OFF_QN = OFF_Z + 32 * MiB;
constexpr size_t OFF_KF = OFF_QN + 32 * MiB;
constexpr size_t OFF_VF = OFF_KF + 32 * MiB;
constexpr size_t WS_END = OFF_VF + 32 * MiB + 16 * MiB;
static_assert(OFF_SSQ == OFF_VF + 32 * MiB, "ssq partials sit after VF");
constexpr int SSQ_STRIDE = M * 32;
constexpr size_t OFF_KFS = OFF_KF, OFF_KFW = OFF_KF + 8 * MiB, OFF_KCG = OFF_KF + 16 * MiB, OFF_VCG = OFF_KF + 24 * MiB;
constexpr size_t OFF_VFS = OFF_VF, OFF_VFW = OFF_VF + 8 * MiB, OFF_Y = OFF_KF + 16 * MiB  , OFF_KFC = OFF_VF + 20 * MiB, OFF_VFC = OFF_VF + 21 * MiB, OFF_GATE = OFF_VF + 22 * MiB;

constexpr int NWAVES = 8, NTHREADS = 512;
constexpr int LDS_BYTES = 147456;
constexpr int NPH = 26;

namespace pg8 {
constexpr int BM = 256, BK = 64, HALF = 128, HTB = HALF * BK * 2, STAGE_BYTES = 8 * HTB, NXCD = 8, WGM = 4;
__device__ __forceinline__ int lds_byte(int r, int c) { const int st = (r >> 4) * 2 + (c >> 5), rr = r & 15, cc = c & 31, ob = rr * 64 + cc * 2; return st * 1024 + (ob ^ (((ob >> 9) & 1) << 5)); }
__device__ __forceinline__ void stage_rc(int b, int& R, int& C) { const int st = b / 1024, sb = b % 1024, swz = sb ^ (((sb >> 9) & 1) << 5); R = (st >> 1) * 16 + swz / 64; C = (st & 1) * 32 + (swz % 64) / 2; }
__device__ __forceinline__ int perm32(int rho) { const int n = rho >> 4, i = rho & 15; return 8 * (i >> 2) + 4 * n + (i & 3); }
struct Unit { int pm, pn; };
struct Gemm { const bf16* A; const bf16* Bt; int M, N, K, lda, ldb, agrp; };
struct StaticOrder {
    int nM, nN, nwg, G, c;
    __device__ void init(int M_, int N_, int G_, int c_) { nM = M_ / BM; nN = N_ / BM; nwg = nM * nN; G = G_; c = c_; }
    __device__ bool next(int i, Unit& u) const {
        const long L = (long)i * G + c; if (L >= nwg) return false;
        int wgid = (int)L; { const int q = nwg / NXCD, r = nwg % NXCD, xcd = wgid % NXCD, off = wgid / NXCD; wgid = (xcd < r ? xcd * (q + 1) : r * (q + 1) + (xcd - r) * q) + off; }
        const int nig = WGM * nM, gid = wgid / nig, fn = gid * WGM, gsz = (nN - fn) < WGM ? (nN - fn) : WGM;
        u.pn = fn + ((wgid % nig) % gsz); u.pm = (wgid % nig) / gsz; return true;
    }
};
__device__ __forceinline__ unsigned cvt_pk_bf16(float lo, float hi) { unsigned r; asm volatile("v_cvt_pk_bf16_f32 %0, %1, %2" : "=v"(r) : "v"(lo), "v"(hi)); return r; }

struct Epi {
    int mode; bf16* O; int ldc; const float* ssq_in; const float* xin; float* xout; float* ssq_out;
    __device__ __forceinline__ void operator()(const f32x4 (&acc)[2][2][4][2], const Unit& u, int wr, int wc, int fr, int fq, int ui, const LAS float* rsl) const {
        const int row0 = u.pm * BM + wr * 64 + fr, col0 = u.pn * BM + wc * 32 + 8 * fq;
        if (mode != 2) {
#pragma unroll
            for (int ai = 0; ai < 2; ++ai)
#pragma unroll
                for (int m = 0; m < 4; ++m) {
                    const int row = row0 + ai * HALF + m * 16;
                    float rs = 1.0f;
                    if (ssq_in && ui < 4) rs = rsl[ui * 256 + ai * HALF + wr * 64 + m * 16 + fr];
                    else if (ssq_in) { const f32x4* pp = (const f32x4*)(ssq_in + (size_t)row * 32); f32x4 s4 = pp[0];
#pragma unroll
                        for (int j = 1; j < 8; ++j) s4 += pp[j];
                        rs = __builtin_amdgcn_rsqf(((s4.x + s4.y) + (s4.z + s4.w)) * (1.0f / D) + EPS); }
                    bf16* rowp = O + (size_t)row * ldc + col0;
#pragma unroll
                    for (int bj = 0; bj < 2; ++bj) {
                        f32x4 v0 = acc[ai][bj][m][0] * rs, v1 = acc[ai][bj][m][1] * rs;
                        if (mode == 1) {
#pragma unroll
                            for (int e = 0; e < 4; ++e) { float a = fmaxf(v0[e], 0.f), b = fmaxf(v1[e], 0.f); v0[e] = a * a; v1[e] = b * b; }
                        }
                        u32x4 w; w.x = cvt_pk_bf16(v0[0], v0[1]); w.y = cvt_pk_bf16(v0[2], v0[3]); w.z = cvt_pk_bf16(v1[0], v1[1]); w.w = cvt_pk_bf16(v1[2], v1[3]);
                        *(u32x4*)(rowp + bj * HALF) = w;
                    }
                }
        } else {
            u32x4 rb[16];
#pragma unroll
            for (int ai = 0; ai < 2; ++ai)
#pragma unroll
                for (int m = 0; m < 4; ++m)
#pragma unroll
                    for (int bj = 0; bj < 2; ++bj) rb[(ai * 4 + m) * 2 + bj] = *(const u32x4*)(O + (size_t)(row0 + ai * HALF + m * 16) * D + col0 + bj * HALF);
            asm volatile("" : "+v"(rb[0]), "+v"(rb[1]), "+v"(rb[2]), "+v"(rb[3]), "+v"(rb[4]), "+v"(rb[5]), "+v"(rb[6]), "+v"(rb[7]));
            asm volatile("" : "+v"(rb[8]), "+v"(rb[9]), "+v"(rb[10]), "+v"(rb[11]), "+v"(rb[12]), "+v"(rb[13]), "+v"(rb[14]), "+v"(rb[15]));
#pragma unroll
            for (int ai = 0; ai < 2; ++ai)
#pragma unroll
                for (int m = 0; m < 4; ++m) {
                    const int row = row0 + ai * HALF + m * 16;
                    float s = 0.f;
#pragma unroll
                    for (int bj = 0; bj < 2; ++bj) {
                        const size_t p = (size_t)row * D + col0 + bj * HALF;
                        const u32x4 rbv = rb[(ai * 4 + m) * 2 + bj];
                        const f32x4 r0 = {__builtin_bit_cast(float, rbv.x << 16), __builtin_bit_cast(float, rbv.x & 0xffff0000u), __builtin_bit_cast(float, rbv.y << 16), __builtin_bit_cast(float, rbv.y & 0xffff0000u)};
                        const f32x4 r1 = {__builtin_bit_cast(float, rbv.z << 16), __builtin_bit_cast(float, rbv.z & 0xffff0000u), __builtin_bit_cast(float, rbv.w << 16), __builtin_bit_cast(float, rbv.w & 0xffff0000u)};
                        const f32x4 v0 = acc[ai][bj][m][0] + r0, v1 = acc[ai][bj][m][1] + r1;
                        if (xout) { *(f32x4*)(xout + p) = v0; *(f32x4*)(xout + p + 4) = v1; }
                        u32x4 w; w.x = cvt_pk_bf16(v0[0], v0[1]); w.y = cvt_pk_bf16(v0[2], v0[3]); w.z = cvt_pk_bf16(v1[0], v1[1]); w.w = cvt_pk_bf16(v1[2], v1[3]);
                        *(u32x4*)(O + p) = w;
                        s += (v0[0] * v0[0] + v0[1] * v0[1]) + (v0[2] * v0[2] + v0[3] * v0[3]) + (v1[0] * v1[0] + v1[1] * v1[1]) + (v1[2] * v1[2] + v1[3] * v1[3]);
                    }
                    s += __shfl_xor(s, 16); s += __shfl_xor(s, 32);
                    if (fq == 0) ssq_out[(size_t)row * 32 + (u.pn & 7) * 4 + wc] = s;
                }
        }
    }
};

template <bool ALIGN_EPI>
__device__ __forceinline__ void gemm_phase(LAS unsigned char* lds, const Gemm g, const StaticOrder& S, const Epi& E, const int tid) {
    const int wid = __builtin_amdgcn_readfirstlane(tid >> 6), lane = tid & 63, wr = wid >> 2, wc = wid & 3, fr = lane & 15, fq = lane >> 4;
    const int K = g.K, nt = K / BK;
    unsigned voffA[2], voffB[2];
#pragma unroll
    for (int i = 0; i < 2; ++i) { int R, C; stage_rc(tid * 16 + i * 8192, R, C); const int Rb = (R & ~31) + perm32(R & 31);
        voffA[i] = (unsigned)(R * g.lda + C) * 2u; voffB[i] = (unsigned)(Rb * g.ldb + C) * 2u; }
    LAS float* rsl = (LAS float*)(lds + STAGE_BYTES);
    const size_t kstep = (size_t)(BK * 2);
    const size_t hstepA = (size_t)HALF * g.lda * 2, hstepB = (size_t)HALF * g.ldb * 2;
    const unsigned ldsw = (unsigned)wid * 1024u;
    const int aoff = lds_byte(wr * 64 + fr, fq * 8), boff = lds_byte(wc * 32 + fr, fq * 8);
#define PG8_SA(b, h) (((b) * 2 + (h)) * HTB)
#define PG8_SB(b, h) ((4 + (b) * 2 + (h)) * HTB)
#define PG8_STAGE(bufoff, gbase, voff) do { _Pragma("unroll") for (int _i = 0; _i < 2; ++_i) \
        __builtin_amdgcn_global_load_lds((const unsigned*)((const char*)(gbase) + (voff)[_i]), (LAS unsigned*)(lds + (bufoff) + ldsw + _i * 8192), 16, 0, 0); } while (0)
#define PG8_LDA(dst, b, h) do { _Pragma("unroll") for (int m = 0; m < 4; ++m) _Pragma("unroll") for (int k = 0; k < 2; ++k) dst[m][k] = *(const LAS bf16x8*)(lds + PG8_SA(b, h) + aoff + m * 2048 + k * 1024); } while (0)
#define PG8_LDB(dst, b, h) do { _Pragma("unroll") for (int n = 0; n < 2; ++n) _Pragma("unroll") for (int k = 0; k < 2; ++k) dst[n][k] = *(const LAS bf16x8*)(lds + PG8_SB(b, h) + boff + n * 2048 + k * 1024); } while (0)
#define PG8_MMA(ai, bj, At, Bt) do { __builtin_amdgcn_s_setprio(1); _Pragma("unroll") for (int m = 0; m < 4; ++m) _Pragma("unroll") for (int n = 0; n < 2; ++n) _Pragma("unroll") for (int k = 0; k < 2; ++k) \
        acc[ai][bj][m][n] = __builtin_amdgcn_mfma_f32_16x16x32_bf16(Bt[n][k], At[m][k], acc[ai][bj][m][n], 0, 0, 0); __builtin_amdgcn_s_setprio(0); } while (0)
#define PG8_WAIT_V(n) asm volatile("s_waitcnt vmcnt(" #n ")" ::: "memory")
#define PG8_WAIT_L(n) asm volatile("s_waitcnt lgkmcnt(" #n ")" ::: "memory")
#define PG8_BAR __builtin_amdgcn_s_barrier()
#define PG8_SCHED __builtin_amdgcn_sched_barrier(0)
    Unit cur, nxt; int ui = 0;
    if (!S.next(0, cur)) return;
    f32x4 acc[2][2][4][2];
#pragma unroll
    for (int a = 0; a < 2; ++a)
#pragma unroll
        for (int b = 0; b < 2; ++b)
#pragma unroll
            for (int m = 0; m < 4; ++m)
#pragma unroll
                for (int n = 0; n < 2; ++n) acc[a][b][m][n] = (f32x4){0.f, 0.f, 0.f, 0.f};
    bf16x8 At[4][2], B0[2][2], B1[2][2];
    const char* cA = (const char*)g.A + (size_t)cur.pm * 2 * hstepA + (g.agrp ? (size_t)(cur.pn >> 1) * 1024 : 0);
    const char* cB = (const char*)g.Bt + (size_t)cur.pn * 2 * hstepB;
    PG8_STAGE(PG8_SB(0, 0), cB, voffB); PG8_STAGE(PG8_SB(0, 1), cB + hstepB, voffB); PG8_STAGE(PG8_SA(0, 0), cA, voffA); PG8_STAGE(PG8_SA(0, 1), cA + hstepA, voffA);
    if (E.mode != 2 && E.ssq_in) {
        for (int i = tid; i < 4 * 256; i += 512) { Unit uu;
            if (S.next(i >> 8, uu)) { const f32x4* pp = (const f32x4*)(E.ssq_in + (size_t)(uu.pm * BM + (i & 255)) * 32); f32x4 s4 = pp[0];
#pragma unroll
                for (int j = 1; j < 8; ++j) s4 += pp[j];
                rsl[i] = __builtin_amdgcn_rsqf(((s4.x + s4.y) + (s4.z + s4.w)) * (1.0f / D) + EPS); } }
    }
    if (wr == 1) PG8_BAR;
    PG8_WAIT_V(2); PG8_BAR;
    PG8_STAGE(PG8_SB(1, 0), cB + kstep, voffB); PG8_STAGE(PG8_SA(1, 0), cA + kstep, voffA); PG8_STAGE(PG8_SB(1, 1), cB + hstepB + kstep, voffB);
    PG8_WAIT_V(6); PG8_BAR;
    for (;;) {
        const bool has_next = S.next(ui + 1, nxt);
        const char* nA = has_next ? (const char*)g.A + (size_t)nxt.pm * 2 * hstepA + (g.agrp ? (size_t)(nxt.pn >> 1) * 1024 : 0) : cA;
        const char* nB = has_next ? (const char*)g.Bt + (size_t)nxt.pn * 2 * hstepB : cB;
        for (int t = 0; t < nt; t += 2) {
            const bool last = (t == nt - 2);
            const char* a1 = cA + (size_t)(t + 1) * kstep;
            const char* a2 = last ? nA : cA + (size_t)(t + 2) * kstep; const char* b2 = last ? nB : cB + (size_t)(t + 2) * kstep;
            const char* a3 = a2 + kstep; const char* b3 = b2 + kstep;
            PG8_LDB(B0, 0, 0); PG8_LDB(B1, 0, 1); PG8_SCHED; PG8_LDA(At, 0, 0); PG8_STAGE(PG8_SA(1, 1), a1 + hstepA, voffA);
            PG8_WAIT_V(8); PG8_WAIT_L(0); PG8_BAR; PG8_MMA(0, 0, At, B0); PG8_MMA(0, 1, At, B1); PG8_BAR; PG8_SCHED;
            PG8_LDA(At, 0, 1); PG8_STAGE(PG8_SB(0, 0), b2, voffB); PG8_STAGE(PG8_SB(0, 1), b2 + hstepB, voffB); PG8_STAGE(PG8_SA(0, 0), a2, voffA);
            PG8_WAIT_V(8); PG8_WAIT_L(0); PG8_BAR; PG8_MMA(1, 0, At, B0); PG8_MMA(1, 1, At, B1); PG8_BAR; PG8_SCHED;
            PG8_LDB(B0, 1, 0); PG8_LDB(B1, 1, 1); PG8_SCHED; PG8_LDA(At, 1, 0); PG8_STAGE(PG8_SA(0, 1), a2 + hstepA, voffA);
            PG8_WAIT_V(8); PG8_WAIT_L(0); PG8_BAR; PG8_MMA(0, 0, At, B0); PG8_MMA(0, 1, At, B1); PG8_BAR; PG8_SCHED;
            PG8_LDA(At, 1, 1); PG8_STAGE(PG8_SB(1, 0), b3, voffB); PG8_STAGE(PG8_SB(1, 1), b3 + hstepB, voffB); PG8_STAGE(PG8_SA(1, 0), a3, voffA);
            PG8_WAIT_V(8); PG8_WAIT_L(0); PG8_BAR; PG8_MMA(1, 0, At, B0); PG8_MMA(1, 1, At, B1); PG8_BAR; PG8_SCHED;
        }
        if constexpr (ALIGN_EPI) { if (wr == 0) PG8_BAR; }
        E(acc, cur, wr, wc, fr, fq, ui, rsl);
        if (!has_next) break;
#pragma unroll
        for (int a = 0; a < 2; ++a)
#pragma unroll
            for (int b = 0; b < 2; ++b)
#pragma unroll
                for (int m = 0; m < 4; ++m)
#pragma unroll
                    for (int n = 0; n < 2; ++n) acc[a][b][m][n] = (f32x4){0.f, 0.f, 0.f, 0.f};
        cur = nxt; cA = nA; cB = nB; ++ui;
        if constexpr (ALIGN_EPI) { if (wr == 1) PG8_BAR; }
    }
    PG8_WAIT_V(0);
    if constexpr (!ALIGN_EPI) { if (wr == 0) PG8_BAR; }
    PG8_BAR;
#undef PG8_SA
#undef PG8_SB
#undef PG8_STAGE
#undef PG8_LDA
#undef PG8_LDB
#undef PG8_MMA
#undef PG8_WAIT_V
#undef PG8_WAIT_L
#undef PG8_BAR
#undef PG8_SCHED
}
}

#define LDS_WAIT() asm volatile("s_waitcnt lgkmcnt(0)" ::: "memory")
__device__ __forceinline__ unsigned f2bf(float f) { unsigned u = __builtin_bit_cast(unsigned, f); return (u + 0x7fffu + ((u >> 16) & 1u)) >> 16; }
typedef float f32x2_t __attribute__((ext_vector_type(2))); typedef __bf16 bf16x2_t __attribute__((ext_vector_type(2)));
__device__ __forceinline__ unsigned pk2(float lo, float hi) { f32x2_t v = {lo, hi}; bf16x2_t b = __builtin_convertvector(v, bf16x2_t); return __builtin_bit_cast(unsigned, b); }
__device__ __forceinline__ float bflo(unsigned w) { return __builtin_bit_cast(float, w << 16); }
__device__ __forceinline__ float bfhi(unsigned w) { return __builtin_bit_cast(float, w & 0xffff0000u); }
__device__ __forceinline__ float bf1(bf16 h) { return __builtin_bit_cast(float, (unsigned)h << 16); }
__device__ __forceinline__ void unpack8(const u32x4 v, float (&f)[8]) { f[0] = bflo(v.x); f[1] = bfhi(v.x); f[2] = bflo(v.y); f[3] = bfhi(v.y); f[4] = bflo(v.z); f[5] = bfhi(v.z); f[6] = bflo(v.w); f[7] = bfhi(v.w); }
__device__ __forceinline__ u32x4 pack8f(const float (&f)[8]) { u32x4 w; w.x = pk2(f[0], f[1]); w.y = pk2(f[2], f[3]); w.z = pk2(f[4], f[5]); w.w = pk2(f[6], f[7]); return w; }
__device__ __forceinline__ float wave_sum(float v) {
#pragma unroll
    for (int o = 1; o < 64; o <<= 1) v += __shfl_xor(v, o);
    return v;
}
__device__ __forceinline__ unsigned cvtpk(float lo, float hi) { f32x2_t v = {lo, hi}; bf16x2_t b = __builtin_convertvector(v, bf16x2_t); return __builtin_bit_cast(unsigned, b); }
#define PIN8(a) asm volatile("" : "+v"(a[0]), "+v"(a[1]), "+v"(a[2]), "+v"(a[3]), "+v"(a[4]), "+v"(a[5]), "+v"(a[6]), "+v"(a[7]))
#define MFMA32(a, b, c) __builtin_amdgcn_mfma_f32_32x32x16_bf16((a), (b), (c), 0, 0, 0)
__device__ __forceinline__ int crow(int r, int hi) { return (r & 3) + 8 * (r >> 2) + 4 * hi; }
__device__ __forceinline__ float ex2(float x) { return __builtin_amdgcn_exp2f(x); }

constexpr int TR_SCR = 64 * 65 * 4;
__device__ __forceinline__ void tr_item(const float* W, int K, int N, bf16* WT, int ldw, int row_off, const float* ksc, const float* nsc, LAS float* scr, int item, int lane) {
    const int nblk = (N + 63) / 64;
    int kb, nb;
    if ((nblk & 3) == 0) { const int q = item >> 3, w = item & 7, nq = nblk >> 2; nb = (q % nq) * 4 + (w & 3); kb = (q / nq) * 2 + (w >> 2); }
    else { kb = item / nblk; nb = item % nblk; }
    const int k0 = 64 * kb, n0 = 64 * nb;
    const int nn = n0 + 4 * (lane & 15), kr = lane >> 4; const bool nok = nn < N;
    f32x4 ns = {1.f, 1.f, 1.f, 1.f};
    if (nsc && nok) ns = *(const f32x4*)(nsc + nn);
    f32x4 v[16];
#pragma unroll
    for (int i = 0; i < 16; ++i) v[i] = nok ? *(const f32x4*)(W + (size_t)(k0 + 4 * i + kr) * N + nn) : (f32x4){0.f, 0.f, 0.f, 0.f};
#pragma unroll
    for (int i = 0; i < 16; ++i) { const int kk = 4 * i + kr; f32x4 x = v[i] * ns; if (ksc) x = x * ksc[k0 + kk];
        LAS float* d = scr + kk * 65 + 4 * (lane & 15); d[0] = x.x; d[1] = x.y; d[2] = x.z; d[3] = x.w; }
    LDS_WAIT(); asm volatile("" ::: "memory");
    const int c = lane & 7;
#pragma unroll
    for (int j = 0; j < 8; ++j) { const int n = (lane >> 3) + 8 * j; const LAS float* sp = scr + (8 * c) * 65 + n;
        u32x4 o; o.x = pk2(sp[0 * 65], sp[1 * 65]); o.y = pk2(sp[2 * 65], sp[3 * 65]); o.z = pk2(sp[4 * 65], sp[5 * 65]); o.w = pk2(sp[6 * 65], sp[7 * 65]);
        if (n0 + n < N) *(u32x4*)(WT + (size_t)(row_off + n0 + n) * ldw + k0 + 8 * c) = o; }
    LDS_WAIT(); asm volatile("" ::: "memory");
}

struct Args { const float* in[21]; float* out; unsigned char* ws; int ph_lo, ph_hi; };

__device__ __forceinline__ void prologue(const Args& a, LAS unsigned char* lds, int wave, int lane, int G, int bid) {
    LAS float* scr = (LAS float*)(lds + wave * TR_SCR);
    const int gw = bid * NWAVES + wave, NGW = G * NWAVES;
    unsigned char* ws = a.ws;
    const float* mixn = a.in[1]; const float* mlpn = a.in[2];
    constexpr int I_W1 = (D / 64) * (FF / 64), I_W2 = (FF / 64) * (D / 64), I_IN = (D / 64) * (6144 / 64), I_SQ = (D / 64) * (D / 64),
                  I_NIN = (D / 64) * ((NSA_W + 63) / 64), I_POOL = (512 / 64) * (512 / 64), I_C1 = (2048 / 64) * (128 / 64);
    constexpr int NITEMS = 4 * I_W1 + 4 * I_W2 + 2 * I_IN + 3 * I_SQ + I_NIN + 4 * I_POOL + 4 * I_C1;
    for (int it = gw; it < NITEMS; it += NGW) {
        int r = it;
        if (r < 4 * I_W1) { const int l = r / I_W1; tr_item(a.in[3] + (size_t)l * D * FF, D, FF, (bf16*)(ws + OFF_W1T) + (size_t)l * D * FF, D, 0, mlpn + l * D, nullptr, scr, r % I_W1, lane); continue; } r -= 4 * I_W1;
        if (r < 4 * I_W2) { const int l = r / I_W2; tr_item(a.in[4] + (size_t)l * D * FF, FF, D, (bf16*)(ws + OFF_W2T) + (size_t)l * D * FF, FF, 0, nullptr, nullptr, scr, r % I_W2, lane); continue; } r -= 4 * I_W2;
        if (r < I_IN) { tr_item(a.in[5], D, 6144, (bf16*)(ws + OFF_CIN), D, 0, mixn + 0 * D, nullptr, scr, r, lane); continue; } r -= I_IN;
        if (r < I_IN) { tr_item(a.in[17], D, 6144, (bf16*)(ws + OFF_SIN), D, 0, mixn + 3 * D, nullptr, scr, r, lane); continue; } r -= I_IN;
        if (r < I_SQ) { tr_item(a.in[7], D, D, (bf16*)(ws + OFF_COUT), D, 0, nullptr, nullptr, scr, r, lane); continue; } r -= I_SQ;
        if (r < I_SQ) { tr_item(a.in[14], D, D, (bf16*)(ws + OFF_NOUT), D, 0, nullptr, nullptr, scr, r, lane); continue; } r -= I_SQ;
        if (r < I_SQ) { tr_item(a.in[20], D, D, (bf16*)(ws + OFF_SOUT), D, 0, nullptr, nullptr, scr, r, lane); continue; } r -= I_SQ;
        if (r < I_NIN) { tr_item(a.in[8], D, NSA_W, (bf16*)(ws + OFF_NIN), D, 0, mixn + 1 * D, nullptr, scr, r, lane); continue; } r -= I_NIN;
        if (r < 4 * I_POOL) { const int gq = r / I_POOL; tr_item(a.in[15] + (size_t)gq * 512 * 512, 512, 512, (bf16*)(ws + OFF_POOL), 512, gq * 512, nullptr, a.in[16] + gq * 512, scr, r % I_POOL, lane); continue; } r -= 4 * I_POOL;
        { const int q = r / I_C1, which = q >> 1, half = q & 1;
          tr_item(a.in[12] + (size_t)which * 4096 * 128 + (size_t)half * 2048 * 128, 2048, 128, (bf16*)(ws + OFF_WC1) + (size_t)which * 256 * 2048, 2048, half * 128, nullptr, nullptr, scr, r % I_C1, lane); }
    }
    {
        const float* x = a.in[0]; bf16* xb = (bf16*)(ws + OFF_XB); float* ssq = (float*)(ws + OFF_SSQ);
        for (int m = gw; m < M; m += NGW) {
            const f32x4* xr = (const f32x4*)(x + (size_t)m * D) + lane; f32x4 v[8]; float s = 0.f;
#pragma unroll
            for (int j = 0; j < 8; ++j) { v[j] = xr[64 * j]; s += (v[j].x * v[j].x + v[j].y * v[j].y) + (v[j].z * v[j].z + v[j].w * v[j].w); }
            s = wave_sum(s);
            if (lane < 32) ssq[(size_t)m * 32 + lane] = lane == 0 ? s : 0.f;
            u32x2* o8 = (u32x2*)(xb + (size_t)m * D) + lane;
#pragma unroll
            for (int j = 0; j < 8; ++j) { u32x2 w; w.x = pk2(v[j].x, v[j].y); w.y = pk2(v[j].z, v[j].w); o8[64 * j] = w; }
        }
    }
    {
        u32x4* p = (u32x4*)((bf16*)(ws + OFF_NIN) + (size_t)NSA_W * D); const int n16 = (NSA_WP - NSA_W) * D * 2 / 16;
        for (int i = gw * 64 + lane; i < n16; i += NGW * 64) p[i] = (u32x4){0u, 0u, 0u, 0u};
    }
    {
        float* part = (float*)(ws + OFF_BIAS1P);
        for (int t = gw; t < 256; t += NGW) {
            const int which = t >> 7, kc = (t >> 1) & 63, n = (t & 1) * 64 + lane;
            const float* pos = a.in[11] + (size_t)which * 4096 + kc * 64; const float* w1 = a.in[12] + (size_t)which * 4096 * 128 + (size_t)kc * 64 * 128 + n;
            float s = 0.f;
#pragma unroll 16
            for (int i = 0; i < 64; ++i) s += pos[i] * w1[i * 128];
            part[(which * 64 + kc) * 128 + n] = s;
        }
    }
}

__device__ __forceinline__ void conv_phase(const bf16* bcv, const float* cw, bf16* z, int G, int tid, int bid) {
    const int half = tid >> 8, c8 = (tid & 255) * 8;
    float w0[8], w1[8], w2[8];
#pragma unroll
    for (int e = 0; e < 8; ++e) { w0[e] = cw[c8 + e]; w1[e] = cw[D + c8 + e]; w2[e] = cw[2 * D + c8 + e]; }
    for (int it = bid; it < M / 16; it += G) {
        const int t0 = it * 16 + half * 8;
        float um2[8], um1[8];
#pragma unroll
        for (int e = 0; e < 8; ++e) { um2[e] = 0.f; um1[e] = 0.f; }
        if ((t0 & (SEQ - 1)) >= 2) {
            float c[8], v[8];
            unpack8(*(const u32x4*)(bcv + (size_t)(t0 - 2) * 6144 + 2048 + c8), c); unpack8(*(const u32x4*)(bcv + (size_t)(t0 - 2) * 6144 + 4096 + c8), v);
#pragma unroll
            for (int e = 0; e < 8; ++e) um2[e] = c[e] * v[e];
            unpack8(*(const u32x4*)(bcv + (size_t)(t0 - 1) * 6144 + 2048 + c8), c); unpack8(*(const u32x4*)(bcv + (size_t)(t0 - 1) * 6144 + 4096 + c8), v);
#pragma unroll
            for (int e = 0; e < 8; ++e) um1[e] = c[e] * v[e];
        }
#pragma unroll
        for (int i = 0; i < 8; ++i) {
            const size_t rb = (size_t)(t0 + i) * 6144;
            float b[8], c[8], v[8], o[8];
            unpack8(*(const u32x4*)(bcv + rb + c8), b); unpack8(*(const u32x4*)(bcv + rb + 2048 + c8), c); unpack8(*(const u32x4*)(bcv + rb + 4096 + c8), v);
#pragma unroll
            for (int e = 0; e < 8; ++e) { const float u = c[e] * v[e]; o[e] = b[e] * (w0[e] * um2[e] + w1[e] * um1[e] + w2[e] * u); um2[e] = um1[e]; um1[e] = u; }
            *(u32x4*)(z + (size_t)(t0 + i) * D + c8) = pack8f(o);
        }
    }
}

__device__ __forceinline__ f32x4 ld4bf(const bf16* p) { const u32x2 w = *(const u32x2*)p; return (f32x4){__builtin_bit_cast(float, w.x << 16), __builtin_bit_cast(float, w.x & 0xffff0000u), __builtin_bit_cast(float, w.y << 16), __builtin_bit_cast(float, w.y & 0xffff0000u)}; }
__device__ __forceinline__ void pool_phase(const bf16* x, const float* ssq, const float* gain, bf16* out, LAS float* rsl, int G, int tid, int bid) {
    const int ch = tid * 4, w = 2 << (tid >> 7);
    const f32x4 gn = *(const f32x4*)(gain + ch);
    for (int it = bid; it < M / 32; it += G) {
        const int t0 = it * 32, tl0 = t0 & (SEQ - 1);
        __syncthreads();
        if (tid < 48) { const int t = t0 - 16 + tid; float r = 0.f;
            if (t >= 0) { const f32x4* pp = (const f32x4*)(ssq + (size_t)t * 32); f32x4 s4 = pp[0];
#pragma unroll
                for (int j = 1; j < 8; ++j) s4 += pp[j];
                r = __builtin_amdgcn_rsqf(((s4.x + s4.y) + (s4.z + s4.w)) * (1.0f / D) + EPS); }
            rsl[tid] = r; }
        __syncthreads();
        f32x4 s = {0.f, 0.f, 0.f, 0.f};
        for (int j = 1; j < w; ++j) if (tl0 - j >= 0) { const int t = t0 - j; s += ld4bf(x + (size_t)t * D + ch) * gn * rsl[16 - j]; }
#pragma unroll 8
        for (int i = 0; i < 32; ++i) {
            const int t = t0 + i, tl = tl0 + i;
            const f32x4 h = ld4bf(x + (size_t)t * D + ch) * gn * rsl[16 + i];
            s += h;
            const int cnt = (tl + 1 < w) ? tl + 1 : w;
            const f32x4 o = s * (1.0f / (float)cnt) - h;
            u32x2 pw; pw.x = pk2(o.x, o.y); pw.y = pk2(o.z, o.w);
            *(u32x2*)(out + (size_t)t * D + ch) = pw;
            if (tl - w + 1 >= 0) { const int tt = t - w + 1; s -= ld4bf(x + (size_t)tt * D + ch) * gn * rsl[16 + i - w + 1]; }
        }
    }
}

__device__ __forceinline__ void ktile_task(const bf16* src, size_t ld, const float* gain, float extra, bool donorm, bf16* dst, size_t dld, int mode, int lane) {
    const int i = lane & 31, hi = lane >> 5;
    u32x4 v[8];
#pragma unroll
    for (int d0 = 0; d0 < 8; ++d0) v[d0] = *(const u32x4*)(src + (size_t)i * ld + 16 * d0 + 8 * hi);
    if (donorm) {
        float ss = 0.f;
#pragma unroll
        for (int d0 = 0; d0 < 8; ++d0) { float f[8]; unpack8(v[d0], f);
#pragma unroll
            for (int e = 0; e < 8; ++e) ss += f[e] * f[e]; }
        ss += __shfl_xor(ss, 32);
        const float r = __builtin_amdgcn_rsqf(ss * (1.0f / HD) + EPS) * extra;
#pragma unroll
        for (int d0 = 0; d0 < 8; ++d0) { float f[8]; unpack8(v[d0], f);
            const f32x4 g0 = *(const f32x4*)(gain + 16 * d0 + 8 * hi), g1 = *(const f32x4*)(gain + 16 * d0 + 8 * hi + 4);
            f[0] *= r * g0.x; f[1] *= r * g0.y; f[2] *= r * g0.z; f[3] *= r * g0.w; f[4] *= r * g1.x; f[5] *= r * g1.y; f[6] *= r * g1.z; f[7] *= r * g1.w;
            v[d0] = pack8f(f); }
    }
#pragma unroll
    for (int d0 = 0; d0 < 8; ++d0) {
        if (mode == 0) *(u32x4*)(dst + (size_t)i * dld + 16 * d0 + 8 * hi) = v[d0];
        else *(u32x4*)(dst + (size_t)(d0 * 64 + lane) * 8) = v[d0];
    }
}
__device__ __forceinline__ void vtile_task(const bf16* src, size_t ld, bf16* dst, int lane, LAS unsigned char* wl) {
    const int i = lane & 31, hi = lane >> 5, dd = lane & 31;
    u32x4 v[8];
#pragma unroll
    for (int d0 = 0; d0 < 8; ++d0) v[d0] = *(const u32x4*)(src + (size_t)i * ld + 16 * d0 + 8 * hi);
#pragma unroll
    for (int d0 = 0; d0 < 8; ++d0) *(LAS u32x4*)(wl + i * 272 + (16 * d0 + 8 * hi) * 2) = v[d0];
    LDS_WAIT(); asm volatile("" ::: "memory");
#pragma unroll
    for (int sd = 0; sd < 8; ++sd) {
        const int s = sd >> 2, db = sd & 3;
        unsigned hv[8];
#pragma unroll
        for (int e = 0; e < 8; ++e) { const int kk = 16 * s + 8 * (e >> 2) + 4 * hi + (e & 3); hv[e] = *(const LAS unsigned short*)(wl + kk * 272 + (32 * db + dd) * 2); }
        u32x4 w; w.x = hv[0] | (hv[1] << 16); w.y = hv[2] | (hv[3] << 16); w.z = hv[4] | (hv[5] << 16); w.w = hv[6] | (hv[7] << 16);
        *(u32x4*)(dst + (size_t)((s * 4 + db) * 64 + lane) * 8) = w;
    }
    LDS_WAIT(); asm volatile("" ::: "memory");
}
__device__ __forceinline__ void cmp_gemm1_task(unsigned char* ws, int tk, int lane);
struct LT { const bf16* src; size_t ld; const float* gain; float extra; bool donorm; bf16* dst; size_t dld; int mode; };
__device__ __forceinline__ void run_lt(const LT& t, int lane, LAS unsigned char* wl) {
    if (t.mode == 2) vtile_task(t.src, t.ld, t.dst, lane, wl);
    else ktile_task(t.src, t.ld, t.gain, t.extra, t.donorm, t.dst, t.dld, t.mode, lane);
}
__device__ __forceinline__ void prep_phase(const Args& a, LAS unsigned char* lds, int wave, int lane, int G, int bid, const bool nsa) {
    unsigned char* ws = a.ws; const bf16* raw = (const bf16*)(ws + OFF_RAW);
    const int gw = bid * NWAVES + wave, NGW = G * NWAVES;
    constexpr int NT_Q = 256 * 16, NT_G = 2 * 4 * 128, NT_C = 2 * 2 * 64 * 8;
    const int ntask = nsa ? NT_C + NT_Q + 4 * NT_G + 256 : 3 * NT_Q;
    if (nsa && gw < 4) {
        const int which = gw >> 1, n = (gw & 1) * 64 + lane; const float* part = (const float*)(ws + OFF_BIAS1P) + which * 64 * 128 + n;
        float sacc = 0.f;
#pragma unroll 16
        for (int kc = 0; kc < 64; ++kc) sacc += part[kc * 128];
        ((float*)(ws + OFF_BIAS1))[which * 128 + n] = sacc;
    }
    for (int tk = gw; tk < ntask; tk += NGW) {
        LT t; bool gate_task = false; int r = tk;
        if (nsa) {
            if (r < NT_C) { cmp_gemm1_task(ws, r, lane); continue; }
            r -= NT_C;
            if (r < NT_Q) { const int tt = r >> 4, hd = r & 15;
                t = LT{raw + (size_t)tt * 32 * NSA_WP + hd * 128, (size_t)NSA_WP, a.in[9], QSCALE, true, (bf16*)(ws + OFF_QN) + ((size_t)tt * 32 * 16 + hd) * 128, 2048, 0}; }
            else if (r < NT_Q + 4 * NT_G) {
                r -= NT_Q;
                const int kind = 2 + r / NT_G, q = r % NT_G, bg = q >> 7, tile = q & 127, b = bg >> 2, g = bg & 3;
                const bf16* src = raw + ((size_t)b * SEQ + tile * 32) * NSA_WP + 2048 + kind * 512 + g * 128;
                const size_t tofs = ((size_t)bg * 128 + tile) * 4096;
                const size_t doff = kind == 2 ? OFF_KFS : kind == 3 ? OFF_VFS : kind == 4 ? OFF_KFW : OFF_VFW;
                const int mode = (kind & 1) ? 2 : 1;
                t = LT{src, (size_t)NSA_WP, a.in[10] + (kind == 2 ? 128 : 256), 1.f, kind == 2 || kind == 4, (bf16*)(ws + doff) + tofs, 128, mode};
            } else { r -= NT_Q + 4 * NT_G; gate_task = true; }
        } else {
            const int kind = r / NT_Q; r = r % NT_Q;
            if (kind == 0) { const int tt = r >> 4, hd = r & 15;
                t = LT{raw + (size_t)tt * 32 * 6144 + hd * 128, 6144, a.in[18], QSCALE, true, (bf16*)(ws + OFF_QN) + ((size_t)tt * 32 * 16 + hd) * 128, 2048, 0}; }
            else { const int bh = r >> 7, tile = r & 127, b = bh >> 4, hd = bh & 15;
                t = LT{raw + ((size_t)b * SEQ + tile * 32) * 6144 + kind * 2048 + hd * 128, 6144, a.in[19], 1.f, kind == 1, (bf16*)(ws + (kind == 1 ? OFF_KF : OFF_VF)) + ((size_t)bh * 128 + tile) * 4096, 128, kind}; }
        }
        if (gate_task) {
            float* gt = (float*)(ws + OFF_GATE);
            for (int i = lane; i < 32 * 48; i += 64) { const int tq = r * 32 + i / 48, c = i % 48; const float v = bf1(raw[(size_t)tq * NSA_WP + 5120 + c]); gt[(size_t)tq * 48 + c] = 1.0f / (1.0f + __expf(-v)); }
        } else run_lt(t, lane, lds + wave * 8704);
    }
}

__device__ __forceinline__ void cmp_gemm1_task(unsigned char* ws, int tk, int lane) {
    const int i = lane & 31, hi = lane >> 5;
    const int kh = tk >> 10, which = (tk >> 9) & 1, mt = (tk >> 3) & 63, nt = tk & 7;
    const int rr = mt * 32 + i, bg = rr >> 8, j = rr & 255, b = bg >> 2, g = bg & 3;
    const bf16* A = (const bf16*)(ws + OFF_RAW) + (size_t)(b * SEQ + 16 * j) * NSA_WP + 2048 + which * 512 + g * 128 + 8 * hi;
    const bf16* Bt = (const bf16*)(ws + OFF_WC1) + (size_t)which * 256 * 2048 + (size_t)(nt * 32 + i) * 2048 + 8 * hi;
    f32x16 acc;
#pragma unroll
    for (int r = 0; r < 16; ++r) acc[r] = 0.f;
    for (int k8 = 8 * kh; k8 < 8 * kh + 8; ++k8) {
        bf16x8 av[8], bv[8];
#pragma unroll
        for (int jj = 0; jj < 8; ++jj) { av[jj] = *(const bf16x8*)(A + (size_t)k8 * NSA_WP + 16 * jj); bv[jj] = *(const bf16x8*)(Bt + 16 * (8 * k8 + jj)); }
        PIN8(av); PIN8(bv);
#pragma unroll
        for (int jj = 0; jj < 8; ++jj) acc = MFMA32(av[jj], bv[jj], acc);
    }
    float* Y = (float*)(ws + OFF_Y) + (size_t)(which * 2 + kh) * 2048 * 256;
#pragma unroll
    for (int r = 0; r < 16; ++r) Y[(size_t)(mt * 32 + crow(r, hi)) * 256 + nt * 32 + i] = acc[r];
}
__device__ __forceinline__ void cmp_stage2(const Args& a, int wave, int lane, int G, int bid) {
    unsigned char* ws = a.ws; const int gw = bid * NWAVES + wave, NGW = G * NWAVES;
    const float* b1 = (const float*)(ws + OFF_BIAS1);
    for (int tk = gw; tk < 2 * 8 * 256; tk += NGW) {
        const int which = tk >> 11, bg = (tk >> 8) & 7, c = tk & 255;
        float o0 = 0.f, o1 = 0.f;
        if (c < 255) {
            const float* Y = (const float*)(ws + OFF_Y) + (size_t)which * 2 * 2048 * 256 + (size_t)(bg * 256 + c) * 256;
            const float* Yh = Y + (size_t)2048 * 256;
            float p0 = (Y[lane] + Yh[lane]) + (Y[256 + 128 + lane] + Yh[256 + 128 + lane]) + b1[which * 128 + lane];
            float p1 = (Y[64 + lane] + Yh[64 + lane]) + (Y[256 + 128 + 64 + lane] + Yh[256 + 128 + 64 + lane]) + b1[which * 128 + 64 + lane];
            const float a0 = p0 / (1.0f + __expf(-p0)), a1 = p1 / (1.0f + __expf(-p1));
            const float* w2 = a.in[13] + (size_t)which * 128 * 128;
            for (int n = 0; n < 64; ++n) {
                const float x0 = __builtin_bit_cast(float, __builtin_amdgcn_readlane(__builtin_bit_cast(int, a0), n));
                const float x1 = __builtin_bit_cast(float, __builtin_amdgcn_readlane(__builtin_bit_cast(int, a1), n));
                o0 += x0 * w2[n * 128 + lane] + x1 * w2[(64 + n) * 128 + lane];
                o1 += x0 * w2[n * 128 + 64 + lane] + x1 * w2[(64 + n) * 128 + 64 + lane];
            }
            if (which == 0) {
                const float ss = wave_sum(o0 * o0 + o1 * o1); const float r = __builtin_amdgcn_rsqf(ss * (1.0f / HD) + EPS);
                o0 *= r * a.in[10][lane]; o1 *= r * a.in[10][64 + lane];
            }
        }
        const int tile = c >> 5, kk = c & 31;
#pragma unroll
        for (int hf = 0; hf < 2; ++hf) {
            const int d = hf * 64 + lane; const bf16 val = (bf16)f2bf(hf ? o1 : o0);
            if (which == 0) { const int d0 = d >> 4, hh = (d >> 3) & 1, e = d & 7;
                ((bf16*)(ws + OFF_KFC))[((size_t)bg * 8 + tile) * 4096 + (size_t)(d0 * 64 + hh * 32 + kk) * 8 + e] = val; }
            else { const int s = kk >> 4, e = ((kk >> 3) & 1) * 4 + (kk & 3), hh = (kk >> 2) & 1, db = d >> 5, dd = d & 31;
                ((bf16*)(ws + OFF_VFC))[((size_t)bg * 8 + tile) * 4096 + (size_t)((s * 4 + db) * 64 + hh * 32 + dd) * 8 + e] = val; }
        }
    }
}

template <class KP>
__device__ __forceinline__ f32x16 qk_tile(KP Kt, const bf16x8 (&qr)[8], int lane) {
    f32x16 p;
#pragma unroll
    for (int r = 0; r < 16; ++r) p[r] = 0.f;
#pragma unroll
    for (int d0 = 0; d0 < 8; ++d0) p = MFMA32(Kt[d0 * 64 + lane], qr[d0], p);
    return p;
}
template <class VP>
__device__ __forceinline__ void pv_tile(VP Vt, const f32x16& p, f32x16 (&o)[4], int lane) {
    u32x4 w0, w1;
    w0.x = cvtpk(p[0], p[1]); w0.y = cvtpk(p[2], p[3]); w0.z = cvtpk(p[4], p[5]); w0.w = cvtpk(p[6], p[7]);
    w1.x = cvtpk(p[8], p[9]); w1.y = cvtpk(p[10], p[11]); w1.z = cvtpk(p[12], p[13]); w1.w = cvtpk(p[14], p[15]);
    const bf16x8 pf0 = __builtin_bit_cast(bf16x8, w0), pf1 = __builtin_bit_cast(bf16x8, w1);
#pragma unroll
    for (int db = 0; db < 4; ++db) { o[db] = MFMA32(Vt[db * 64 + lane], pf0, o[db]); o[db] = MFMA32(Vt[(4 + db) * 64 + lane], pf1, o[db]); }
}
template <class KP, class VP, class VF>
__device__ __forceinline__ void flash_step(KP Kt, VP Vt, const bf16x8 (&qr)[8], f32x16 (&o)[4], float& m, float& l, int lane, VF valid) {
    f32x16 p = qk_tile(Kt, qr, lane);
    __builtin_amdgcn_sched_barrier(0);
    const int hi = lane >> 5;
    float mx = NEGF;
#pragma unroll
    for (int r = 0; r < 16; ++r) { const bool v = valid(crow(r, hi)); p[r] = v ? p[r] : NEGF; mx = fmaxf(mx, p[r]); }
    mx = fmaxf(mx, __shfl_xor(mx, 32));
    const float mn = fmaxf(m, mx);
    const float alpha = ex2(m - mn);
    m = mn;
    float ls = 0.f;
#pragma unroll
    for (int r = 0; r < 16; ++r) { const float e = (p[r] > -1e29f) ? ex2(p[r] - mn) : 0.f; p[r] = e; ls += e; }
    l = l * alpha + ls;
    if (__any(alpha != 1.0f)) {
#pragma unroll
        for (int db = 0; db < 4; ++db)
#pragma unroll
            for (int r = 0; r < 16; ++r) o[db][r] *= alpha;
    }
    pv_tile(Vt, p, o, lane);
}
template <class VF>
__device__ __forceinline__ void flash_step_lds(const LAS bf16x8* Kt, const LAS bf16x8* Vt, const bf16x8 (&qr)[8], f32x16 (&o)[4], float& m, float& l, int lane, bool rowok, bool need_elem, VF valid) {
    bf16x8 kf[8], vf[8];
#pragma unroll
    for (int d0 = 0; d0 < 8; ++d0) kf[d0] = Kt[d0 * 64 + lane];
    PIN8(kf);
    f32x16 p;
#pragma unroll
    for (int r = 0; r < 16; ++r) p[r] = 0.f;
    __builtin_amdgcn_s_setprio(1);
#pragma unroll
    for (int d0 = 0; d0 < 8; ++d0) p = MFMA32(kf[d0], qr[d0], p);
    __builtin_amdgcn_s_setprio(0);
    __builtin_amdgcn_sched_barrier(0);
#pragma unroll
    for (int i = 0; i < 8; ++i) vf[i] = Vt[i * 64 + lane];
    __builtin_amdgcn_sched_barrier(0);
    const int hi = lane >> 5;
    float mx = NEGF;
    if (need_elem) {
#pragma unroll
        for (int r = 0; r < 16; ++r) { const bool v = rowok && valid(crow(r, hi)); p[r] = v ? p[r] : NEGF; mx = fmaxf(mx, p[r]); }
    } else {
#pragma unroll
        for (int r = 0; r < 16; ++r) { p[r] = rowok ? p[r] : NEGF; mx = fmaxf(mx, p[r]); }
    }
    mx = fmaxf(mx, __shfl_xor(mx, 32));
    if (__any(mx > m + 8.0f)) {
        const float mn = fmaxf(m, mx);
        const float alpha = ex2(m - mn);
        m = mn; l *= alpha;
#pragma unroll
        for (int db = 0; db < 4; ++db)
#pragma unroll
            for (int r = 0; r < 16; ++r) o[db][r] *= alpha;
    }
    float ls = 0.f;
    if (need_elem) {
#pragma unroll
        for (int r = 0; r < 16; ++r) { const float e = (p[r] > -1e29f) ? ex2(p[r] - m) : 0.f; p[r] = e; ls += e; }
    } else {
#pragma unroll
        for (int r = 0; r < 16; ++r) { const float e = ex2(p[r] - m); p[r] = e; ls += e; }
    }
    l += ls;
    u32x4 w0, w1;
    w0.x = cvtpk(p[0], p[1]); w0.y = cvtpk(p[2], p[3]); w0.z = cvtpk(p[4], p[5]); w0.w = cvtpk(p[6], p[7]);
    w1.x = cvtpk(p[8], p[9]); w1.y = cvtpk(p[10], p[11]); w1.z = cvtpk(p[12], p[13]); w1.w = cvtpk(p[14], p[15]);
    const bf16x8 pf0 = __builtin_bit_cast(bf16x8, w0), pf1 = __builtin_bit_cast(bf16x8, w1);
#pragma unroll
    for (int db = 0; db < 4; ++db) { o[db] = MFMA32(vf[db], pf0, o[db]); o[db] = MFMA32(vf[4 + db], pf1, o[db]); }
}
__device__ __forceinline__ void zero_o(f32x16 (&o)[4]) {
#pragma unroll
    for (int db = 0; db < 4; ++db)
#pragma unroll
        for (int r = 0; r < 16; ++r) o[db][r] = 0.f;
}
__device__ __forceinline__ void store_o(const f32x16 (&o)[4], bf16* orow  , int hi) {
#pragma unroll
    for (int db = 0; db < 4; ++db)
#pragma unroll
        for (int gq = 0; gq < 4; ++gq) { u32x2 w; w.x = cvtpk(o[db][4 * gq], o[db][4 * gq + 1]); w.y = cvtpk(o[db][4 * gq + 2], o[db][4 * gq + 3]);
            *(u32x2*)(orow + 32 * db + 8 * gq + 4 * hi) = w; }
}

constexpr size_t OFF_OST2 = OFF_RAW;
constexpr size_t OFF_OST = OFF_H, OFF_SELM = OFF_H + 64 * MiB, OFF_UM = OFF_SELM + 512 * 1024;
__device__ __forceinline__ void nsa_unit(int pp, int half, int& bg, int& tb) { bg = pp & 7; tb = half ? (pp >> 3) : 63 - (pp >> 3); }
__device__ __forceinline__ void load_q(bf16x8 (&qr)[8], const unsigned char* ws, int row, int head, int hi) {
    const bf16* qp = (const bf16*)(ws + OFF_QN) + ((size_t)row * 16 + head) * 128 + 8 * hi;
#pragma unroll
    for (int d0 = 0; d0 < 8; ++d0) qr[d0] = *(const bf16x8*)(qp + 16 * d0);
}
template <class F>
__device__ __forceinline__ void ring_sweep(LAS unsigned char* ring, const unsigned char* Kb, const unsigned char* Vb, unsigned toff, int wave, int Tfirst, int Tmax, unsigned long long um, F f) {
#define RS_NEXT(Tc) ({ int Tn_ = (Tc) + 1; while (Tn_ <= Tmax && !((um >> (Tn_ >> 1)) & 1ull)) ++Tn_; Tn_; })
#define RS_DMA(Tt, slot) do { LAS unsigned char* d_ = ring + (slot) * 16384 + wave * 1024; \
        __builtin_amdgcn_global_load_lds((const unsigned*)(Kb + (unsigned)(Tt) * 8192u + toff), (LAS unsigned*)d_, 16, 0, 0); \
        __builtin_amdgcn_global_load_lds((const unsigned*)(Vb + (unsigned)(Tt) * 8192u + toff), (LAS unsigned*)(d_ + 8192), 16, 0, 0); } while (0)
    __builtin_amdgcn_s_barrier();
    int Ta = Tfirst, Tb = Ta <= Tmax ? RS_NEXT(Ta) : Tmax + 1, Tc = Tb <= Tmax ? RS_NEXT(Tb) : Tmax + 1, slot = 0;
    if (Ta <= Tmax) RS_DMA(Ta, 0);
    if (Tb <= Tmax) RS_DMA(Tb, 1);
    if (Tc <= Tmax) RS_DMA(Tc, 2);
    while (Ta <= Tmax) {
        if (Tc <= Tmax) asm volatile("s_waitcnt vmcnt(4)" ::: "memory");
        else if (Tb <= Tmax) asm volatile("s_waitcnt vmcnt(2)" ::: "memory");
        else asm volatile("s_waitcnt vmcnt(0)" ::: "memory");
        __builtin_amdgcn_s_barrier();
        __builtin_amdgcn_sched_barrier(0);
        const int Td = Tc <= Tmax ? RS_NEXT(Tc) : Tmax + 1;
        if (Td <= Tmax) RS_DMA(Td, (slot + 3) & 3);
        LAS unsigned char* tp = ring + slot * 16384;
        f(Ta, (const LAS bf16x8*)tp, (const LAS bf16x8*)(tp + 8192));
        Ta = Tb; Tb = Tc; Tc = Td; slot = (slot + 1) & 3;
    }
#undef RS_NEXT
#undef RS_DMA
}
__device__ __forceinline__ void nsa_cmp(const Args& a, LAS unsigned char* lds, int wave, int lane, int G, int bid, int tid) {
    unsigned char* ws = a.ws;
    LAS float* impH = (LAS float*)(lds + 65536);
    LAS unsigned long long* ump = (LAS unsigned long long*)(lds + 131072);
    const int q = lane & 31, hi = lane >> 5, h = wave & 3, sub = wave >> 2;
    const float* gates = (const float*)(ws + OFF_GATE);
    const unsigned toff = (unsigned)tid * 16u;
    for (int pp = bid; pp < 256; pp += G)
        for (int half = 0; half < 2; ++half) {
            int bg, tb; nsa_unit(pp, half, bg, tb);
            const int b = bg >> 2, g = bg & 3, unit = bg * 64 + tb;
            const int t0 = tb * 64 + sub * 32, t = t0 + q, row = b * SEQ + t, head = g * 4 + h;
            bf16x8 qr[8]; load_q(qr, ws, row, head, hi);
            f32x16 o[4];
            const unsigned char* Kb = ws + OFF_KFC + (size_t)bg * 8 * 8192;
            const unsigned char* Vb = ws + OFF_VFC + (size_t)bg * 8 * 8192;
            const int nTc = (t0 >> 9) + 1;
            float m = NEGF, l = 0.f;
            zero_o(o);
            ring_sweep(lds, Kb, Vb, toff, wave, 0, nTc - 1, ~0ull, [&](int T, const LAS bf16x8* Kt, const LAS bf16x8* Vt) {
                flash_step_lds(Kt, Vt, qr, o, m, l, lane, true, T >= nTc - 2, [=](int kk) { return 16 * (32 * T + kk) + 31 <= t; }); });
            const float lt = l + __shfl_xor(l, 32);
            {
                unsigned* ostw = (unsigned*)(ws + OFF_OST) + (size_t)(unit * NWAVES + wave) * 2048;
                const float inv = lt > 0.f ? gates[(unsigned)(row * 48 + head * 3 + 0)] / lt : 0.f;
#pragma unroll
                for (int db = 0; db < 4; ++db)
#pragma unroll
                    for (int r = 0; r < 16; r += 2) ostw[(unsigned)((db * 8 + (r >> 1)) * 64 + lane)] = cvtpk(o[db][r] * inv, o[db][r + 1] * inv);
            }
            {
                const float invl = lt > 0.f ? 1.0f / lt : 0.f;
                float prevB = 0.f;
                LAS float* dst = impH + ((sub * 4 + h) * 32 + q) * 64;
                ring_sweep(lds, Kb, Vb, toff, wave, 0, nTc - 1, ~0ull, [&](int T, const LAS bf16x8* Kt, const LAS bf16x8* Vt) {
                    f32x16 p = qk_tile(Kt, qr, lane);
#pragma unroll
                    for (int r = 0; r < 16; ++r) { const bool v = 16 * (32 * T + crow(r, hi)) + 31 <= t; p[r] = v ? ex2(p[r] - m) * invl : 0.f; }
                    float Bp[4];
#pragma unroll
                    for (int gg = 0; gg < 4; ++gg) Bp[gg] = __shfl_xor(p[4 * gg + 3], 32);
#pragma unroll
                    for (int gg = 0; gg < 4; ++gg) {
                        const float A = (p[4 * gg] + p[4 * gg + 1]) + (p[4 * gg + 2] + p[4 * gg + 3]);
                        const float Bv = hi ? Bp[gg] : (gg ? Bp[gg ? gg - 1 : 0] : prevB);
                        dst[8 * T + 2 * gg + hi] = A + Bv;
                    }
                    prevB = Bp[3];
                });
            }
            __syncthreads();
            {
                unsigned long long wm = 0ull;
                unsigned long long* selm = (unsigned long long*)(ws + OFF_SELM) + (size_t)unit * 64;
                for (int jj = 0; jj < 8; ++jj) {
                    const int j = wave * 8 + jj, sj = j >> 5, qj = j & 31, s = lane, cur = tb;
                    float v = 0.f;
                    if (s <= tb) { const LAS float* src = impH + (sj * 4 * 32 + qj) * 64 + s; v = (src[0] + src[32 * 64]) + (src[2 * 32 * 64] + src[3 * 32 * 64]); }
                    const bool valid = s <= cur, forced = (s == 0) || (s == cur) || (s == cur - 1);
                    const float val = forced ? 1e4f : (valid ? v : -1e4f);
                    int rank = 0;
                    for (int jx = 0; jx < 64; ++jx) { const float ov = __builtin_bit_cast(float, __builtin_amdgcn_readlane(__builtin_bit_cast(int, val), jx)); rank += ((ov > val) || (ov == val && jx < lane)) ? 1 : 0; }
                    const unsigned long long mk = __ballot(rank < 16 && valid);
                    if (lane == 0) selm[j] = mk;
                    wm |= mk;
                }
                if (lane == 0) ump[wave] = wm;
            }
            __syncthreads();
            if (wave == 0 && lane == 0) { unsigned long long um = 0ull;
#pragma unroll
                for (int w8 = 0; w8 < 8; ++w8) um |= ump[w8];
                ((unsigned long long*)(ws + OFF_UM))[unit] = um; }
        }
}
template <bool WIN>
__device__ __forceinline__ void nsa_sweep(const Args& a, LAS unsigned char* lds, int wave, int lane, int G, int bid, int tid) {
    unsigned char* ws = a.ws;
    const int q = lane & 31, hi = lane >> 5, h = wave & 3, sub = wave >> 2;
    const float* gates = (const float*)(ws + OFF_GATE);
    const unsigned toff = (unsigned)tid * 16u;
    for (int pp = bid; pp < 256; pp += G)
        for (int half = 0; half < 2; ++half) {
            int bg, tb; nsa_unit(pp, half, bg, tb);
            const int b = bg >> 2, g = bg & 3, unit = bg * 64 + tb;
            const int t0 = tb * 64 + sub * 32, t = t0 + q, row = b * SEQ + t, head = g * 4 + h;
            bf16x8 qr[8]; load_q(qr, ws, row, head, hi);
            unsigned long long msk = ~0ull, um = ~0ull;
            if (!WIN) { msk = ((const unsigned long long*)(ws + OFF_SELM))[(unsigned)(unit * 64 + sub * 32 + q)]; um = ((const unsigned long long*)(ws + OFF_UM))[unit]; }
            const unsigned char* Kb = ws + (WIN ? OFF_KFW : OFF_KFS) + (size_t)bg * 128 * 8192;
            const unsigned char* Vb = ws + (WIN ? OFF_VFW : OFF_VFS) + (size_t)bg * 128 * 8192;
            f32x16 o[4]; zero_o(o);
            float m = NEGF, l = 0.f;
            const int Tmax = 2 * tb + 1;
            const int Tfirst = WIN ? (2 * tb >= 16 ? 2 * tb - 16 : 0) : 0;
            ring_sweep(lds, Kb, Vb, toff, wave, Tfirst, Tmax, um, [&](int T, const LAS bf16x8* Kt, const LAS bf16x8* Vt) {
                const int Td = t0 >> 5;
                if (WIN) flash_step_lds(Kt, Vt, qr, o, m, l, lane, true, (T >= Td) || (T <= Td - 16), [=](int kk) { const int key = 32 * T + kk; return key <= t && t - key < 512; });
                else { const bool bit = (msk >> (T >> 1)) & 1ull;
                    flash_step_lds(Kt, Vt, qr, o, m, l, lane, bit, T >= Td, [=](int kk) { return 32 * T + kk <= t; }); } });
            const float lt = l + __shfl_xor(l, 32);
            const float inv = lt > 0.f ? gates[(unsigned)(row * 48 + head * 3 + (WIN ? 2 : 1))] / lt : 0.f;
            const unsigned* osrc = (const unsigned*)(ws + (WIN ? OFF_OST2 : OFF_OST)) + (size_t)(unit * NWAVES + wave) * 2048;
            int lane2 = lane; asm volatile("" : "+v"(lane2));
            unsigned* ostw = (unsigned*)(ws + OFF_OST2) + (size_t)(unit * NWAVES + wave) * 2048;
#pragma unroll
            for (int db = 0; db < 4; ++db) {
#pragma unroll
                for (int r = 0; r < 16; r += 2) { const unsigned w = osrc[(unsigned)((db * 8 + (r >> 1)) * 64 + lane2)]; o[db][r] = bflo(w) + o[db][r] * inv; o[db][r + 1] = bfhi(w) + o[db][r + 1] * inv; }
                __builtin_amdgcn_sched_barrier(0); }
            if (WIN) store_o(o, (bf16*)(ws + OFF_Z) + (unsigned)(row * D + head * 128), hi);
            else {
#pragma unroll
                for (int db = 0; db < 4; ++db)
#pragma unroll
                    for (int r = 0; r < 16; r += 2) ostw[(unsigned)((db * 8 + (r >> 1)) * 64 + lane)] = cvtpk(o[db][r], o[db][r + 1]);
            }
        }
}

__device__ __forceinline__ void sb_core(const Args& a, int wave, int lane, int G, int bid) {
    unsigned char* ws = a.ws;
    const int q = lane & 31, hi = lane >> 5;
    for (int u = bid; u < 512; u += G) {
        const int bh = u >> 4, tb = u & 15, b = bh >> 4, head = bh & 15;
        const int t0 = tb * 256 + wave * 32, t = t0 + q, row = b * SEQ + t;
        bf16x8 qr[8];
        { const bf16* qp = (const bf16*)(ws + OFF_QN) + ((size_t)row * 16 + head) * 128 + 8 * hi;
#pragma unroll
          for (int d0 = 0; d0 < 8; ++d0) qr[d0] = *(const bf16x8*)(qp + 16 * d0); }
        const bf16x8* Kb = (const bf16x8*)(ws + OFF_KF) + (size_t)bh * 128 * 512;
        const bf16x8* Vb = (const bf16x8*)(ws + OFF_VF) + (size_t)bh * 128 * 512;
        f32x16 o[4]; zero_o(o);
        float carry = 1.0f;
        bf16x8 kf[8];
#pragma unroll
        for (int d0 = 0; d0 < 8; ++d0) kf[d0] = Kb[(size_t)(t0 >> 5) * 512 + d0 * 64 + lane];
        for (int T = t0 >> 5; T >= 0; --T) {
            bf16x8 vf[8];
            PIN8(kf);
#pragma unroll
            for (int i = 0; i < 8; ++i) vf[i] = Vb[(size_t)T * 512 + i * 64 + lane];
            f32x16 p;
#pragma unroll
            for (int r = 0; r < 16; ++r) p[r] = 0.f;
#pragma unroll
            for (int d0 = 0; d0 < 8; ++d0) p = MFMA32(kf[d0], qr[d0], p);
            __builtin_amdgcn_sched_barrier(0);
            {
                const int Tn = T > 0 ? T - 1 : 0;
#pragma unroll
                for (int d0 = 0; d0 < 8; ++d0) kf[d0] = Kb[(size_t)Tn * 512 + d0 * 64 + lane];
            }
            __builtin_amdgcn_sched_barrier(0);
            float rv[16];
#pragma unroll
            for (int r = 0; r < 16; ++r) {
                const int key = 32 * T + crow(r, hi);
                const float e = ex2(fminf(p[r], 80.f)); const float rr = __builtin_amdgcn_rcpf(1.0f + e);
                const bool ok = key < t;
                rv[r] = ok ? rr : 1.0f; p[r] = ok ? e * rr : 0.f;
            }
            float Gp[4], Tt[4];
#pragma unroll
            for (int gg = 0; gg < 4; ++gg) { const float Gm = (rv[4 * gg] * rv[4 * gg + 1]) * (rv[4 * gg + 2] * rv[4 * gg + 3]); Gp[gg] = __shfl_xor(Gm, 32); Tt[gg] = Gm * Gp[gg]; }
            float suf = carry;
#pragma unroll
            for (int gg = 3; gg >= 0; --gg) {
                float w = suf * (hi ? 1.0f : Gp[gg]);
                p[4 * gg + 3] *= w; w *= rv[4 * gg + 3];
                p[4 * gg + 2] *= w; w *= rv[4 * gg + 2];
                p[4 * gg + 1] *= w; w *= rv[4 * gg + 1];
                p[4 * gg] *= w;
                suf *= Tt[gg];
            }
            carry = suf;
            {
                u32x4 w0, w1;
                w0.x = cvtpk(p[0], p[1]); w0.y = cvtpk(p[2], p[3]); w0.z = cvtpk(p[4], p[5]); w0.w = cvtpk(p[6], p[7]);
                w1.x = cvtpk(p[8], p[9]); w1.y = cvtpk(p[10], p[11]); w1.z = cvtpk(p[12], p[13]); w1.w = cvtpk(p[14], p[15]);
                const bf16x8 pf0 = __builtin_bit_cast(bf16x8, w0), pf1 = __builtin_bit_cast(bf16x8, w1);
#pragma unroll
                for (int db = 0; db < 4; ++db) { o[db] = MFMA32(vf[db], pf0, o[db]); o[db] = MFMA32(vf[4 + db], pf1, o[db]); }
            }
            if (!__any(carry > 1e-37f)) break;
        }
        store_o(o, (bf16*)(ws + OFF_Z) + (size_t)row * D + head * 128, hi);
    }
}


#define XB_TMO      128
#define XB_XCNT(j)  (256  + 64 * (j))
#define XB_XSUB(j)  (1280 + 64 * (j))
#define XB_XGEN(j)  (2304 + 64 * (j))
#define XB_TOP      3328
#define XB_TOPGEN   3392
#define XCD_BAR_WORDS 3456
#define XB_SPIN_CAP (1u << 20)
__device__ __forceinline__ unsigned xb_ld(unsigned* p)              { return __hip_atomic_load(p, __ATOMIC_RELAXED, __HIP_MEMORY_SCOPE_AGENT); }
__device__ __forceinline__ unsigned xb_add(unsigned* p, unsigned v) { return __hip_atomic_fetch_add(p, v, __ATOMIC_RELAXED, __HIP_MEMORY_SCOPE_AGENT); }
__device__ __forceinline__ unsigned xb_xcc_id() { return (unsigned)__builtin_amdgcn_s_getreg((3 << 11) | 20) & 0xFu; }
#define XB_SPIN(cond, bar) do { unsigned _sp = 0; while (cond) { __builtin_amdgcn_s_sleep(1); \
    if ((++_sp & 255u) == 0u) { if (xb_ld(&(bar)[XB_TMO])) break; if (_sp > XB_SPIN_CAP) { atomicAdd(&(bar)[XB_TMO], 1u); break; } } } } while (0)
struct XcdBarrier { unsigned* bar; unsigned x; volatile LAS unsigned* st; };
__device__ __forceinline__ XcdBarrier xcd_barrier_post(unsigned* bar, volatile LAS unsigned* st) {
    XcdBarrier b; b.bar = bar; b.x = xb_xcc_id(); b.st = st;
    if (threadIdx.x == 0) (void)xb_add(&bar[XB_XCNT(b.x)], 1u);
    return b;
}
__device__ __forceinline__ void xcd_barrier_complete(unsigned* bar, unsigned x, unsigned& nloc, unsigned& nx) {
    const unsigned G = gridDim.x * gridDim.y * gridDim.z;
    unsigned sum, cnt, mine, sp = 0u;
    for (;;) {
        sum = 0u; cnt = 0u; mine = 0u;
#pragma unroll
        for (unsigned j = 0; j < 16; ++j) { const unsigned c = xb_ld(&bar[XB_XCNT(j)]); sum += c; cnt += (c > 0u) ? 1u : 0u; mine = (j == x) ? c : mine; }
        if (sum == G) break;
        __builtin_amdgcn_s_sleep(1);
        if ((++sp & 255u) == 0u) { if (xb_ld(&bar[XB_TMO])) break; if (sp > XB_SPIN_CAP) { atomicAdd(&bar[XB_TMO], 1u); break; } }
    }
    nloc = mine > 0u ? mine : 1u; nx = cnt > 0u ? cnt : 1u;
}
__device__ __forceinline__ void xcd_barrier(const XcdBarrier& b) {
    asm volatile("s_waitcnt vmcnt(0)" ::: "memory");
    __syncthreads();
    if (threadIdx.x == 0) {
        unsigned* bar = b.bar;
        __builtin_amdgcn_s_waitcnt(0);
        unsigned nloc = b.st[0], nx = b.st[1];
        if (nloc == 0u) { xcd_barrier_complete(bar, b.x, nloc, nx); b.st[0] = nloc; b.st[1] = nx; }
        const unsigned old = xb_add(&bar[XB_XSUB(b.x)], 1u);
        const unsigned gen = old / nloc;
        if (old + 1u == (gen + 1u) * nloc) {
            __builtin_amdgcn_fence(__ATOMIC_RELEASE, "agent");
            asm volatile("s_waitcnt vmcnt(0)" ::: "memory");
            const unsigned og = xb_add(&bar[XB_TOP], 1u);
            const unsigned tg = og / nx;
            if (og + 1u == (tg + 1u) * nx) xb_add(&bar[XB_TOPGEN], 1u);
            else XB_SPIN(xb_ld(&bar[XB_TOPGEN]) == tg, bar);
            __builtin_amdgcn_fence(__ATOMIC_ACQUIRE, "agent");
            xb_add(&bar[XB_XGEN(b.x)], 1u);
            asm volatile("s_waitcnt vmcnt(0)" ::: "memory");
        } else {
            XB_SPIN(xb_ld(&bar[XB_XGEN(b.x)]) == gen, bar);
            __builtin_amdgcn_fence(__ATOMIC_ACQUIRE, "agent");
            asm volatile("s_waitcnt vmcnt(0)" ::: "memory");
        }
    }
    __syncthreads();
}

__device__ __forceinline__ bool gemm_desc(int ph, const Args& a, pg8::Gemm& g, pg8::Epi& E) {
    unsigned char* ws = a.ws;
    bf16* xb = (bf16*)(ws + OFF_XB); bf16* hb = (bf16*)(ws + OFF_H); bf16* raw = (bf16*)(ws + OFF_RAW); bf16* z = (bf16*)(ws + OFF_Z);
    float* ssq = (float*)(ws + OFF_SSQ);
    auto act = [&](const bf16* A, const bf16* Bt, int N, int K, bf16* O, int ldc, const float* sq, int mode) {
        g = pg8::Gemm{A, Bt, M, N, K, K, K, 0}; E = pg8::Epi{mode, O, ldc, sq, nullptr, nullptr, nullptr}; };
    auto res = [&](const bf16* A, const bf16* Bt, int K, int lda, int ldb, int agrp, const float* xin, float* sq_out) {
        g = pg8::Gemm{A, Bt, M, D, K, lda, ldb, agrp}; E = pg8::Epi{2, xb, D, nullptr, xin, ph == 25 ? a.out : nullptr, sq_out}; };
    switch (ph) {
        case 1: act(xb, (const bf16*)(ws + OFF_CIN), 6144, D, raw, 6144, ssq + 0 * SSQ_STRIDE, 0); return true;
        case 3: res(z, (const bf16*)(ws + OFF_COUT), D, D, D, 0, a.in[0], ssq + 1 * SSQ_STRIDE); return true;
        case 4: act(xb, (const bf16*)(ws + OFF_W1T), FF, D, hb, FF, ssq + 1 * SSQ_STRIDE, 1); return true;
        case 5: res(hb, (const bf16*)(ws + OFF_W2T), FF, FF, FF, 0, a.out, ssq + 2 * SSQ_STRIDE); return true;
        case 6: act(xb, (const bf16*)(ws + OFF_NIN), NSA_WP, D, raw, NSA_WP, ssq + 2 * SSQ_STRIDE, 0); return true;
        case 13: res(z, (const bf16*)(ws + OFF_NOUT), D, D, D, 0, a.out, ssq + 3 * SSQ_STRIDE); return true;
        case 14: act(xb, (const bf16*)(ws + OFF_W1T) + (size_t)1 * D * FF, FF, D, hb, FF, ssq + 3 * SSQ_STRIDE, 1); return true;
        case 15: res(hb, (const bf16*)(ws + OFF_W2T) + (size_t)1 * D * FF, FF, FF, FF, 0, a.out, ssq + 4 * SSQ_STRIDE); return true;
        case 17: res(z, (const bf16*)(ws + OFF_POOL), 512, D, 512, 1, a.out, ssq + 5 * SSQ_STRIDE); return true;
        case 18: act(xb, (const bf16*)(ws + OFF_W1T) + (size_t)2 * D * FF, FF, D, hb, FF, ssq + 5 * SSQ_STRIDE, 1); return true;
        case 19: res(hb, (const bf16*)(ws + OFF_W2T) + (size_t)2 * D * FF, FF, FF, FF, 0, a.out, ssq + 6 * SSQ_STRIDE); return true;
        case 20: act(xb, (const bf16*)(ws + OFF_SIN), 6144, D, raw, 6144, ssq + 6 * SSQ_STRIDE, 0); return true;
        case 23: res(z, (const bf16*)(ws + OFF_SOUT), D, D, D, 0, a.out, ssq + 7 * SSQ_STRIDE); return true;
        case 24: act(xb, (const bf16*)(ws + OFF_W1T) + (size_t)3 * D * FF, FF, D, hb, FF, ssq + 7 * SSQ_STRIDE, 1); return true;
        case 25: res(hb, (const bf16*)(ws + OFF_W2T) + (size_t)3 * D * FF, FF, FF, FF, 0, a.out, ssq + 8 * SSQ_STRIDE); return true;
        default: return false;
    }
}

__global__ void __launch_bounds__(NTHREADS, 2) fwd_kernel(Args arg) {
    extern __shared__ __attribute__((aligned(16))) unsigned char lds_raw[];
    LAS unsigned char* lds = (LAS unsigned char*)lds_raw;
    typedef const volatile __attribute__((address_space(4))) unsigned long long* kvptr;
    const int ph_lo = arg.ph_lo, ph_hi = arg.ph_hi;
    volatile LAS unsigned* bst = (volatile LAS unsigned*)(lds + LDS_BYTES - 64);
    if (threadIdx.x < 2) bst[threadIdx.x] = 0u;
    __syncthreads();
    XcdBarrier xbar = xcd_barrier_post((unsigned*)(arg.ws + OFF_CTL), bst);
    for (int pi = ph_lo; pi < ph_hi; ++pi) {
        int ph = 0; if (DUPMASK) { int c = pi; for (;;) { const int reps = ((DUPMASK >> ph) & 1ull) ? 2 : 1; if (c < reps) break; c -= reps; ++ph; } } else ph = pi;
        if (ph == 8) continue;
        Args a;
        { kvptr kp = (kvptr)__builtin_amdgcn_kernarg_segment_ptr();
#pragma unroll
          for (int i = 0; i < 21; ++i) a.in[i] = (const float*)(const __attribute__((address_space(1))) float*)(uintptr_t)kp[i];
          a.out = (float*)(__attribute__((address_space(1))) float*)(uintptr_t)kp[21]; a.ws = (unsigned char*)(__attribute__((address_space(1))) unsigned char*)(uintptr_t)kp[22]; a.ph_lo = ph_lo; a.ph_hi = ph_hi; }
        unsigned char* ws = a.ws;
        int tid = threadIdx.x, G = gridDim.x, bid = blockIdx.x;
        asm volatile("" : "+v"(tid)); asm volatile("" : "+s"(G)); asm volatile("" : "+s"(bid));
        const int lane = tid & 63, wave = __builtin_amdgcn_readfirstlane(tid >> 6);
        pg8::Gemm g; pg8::Epi E;
        if (gemm_desc(ph, a, g, E)) {
            if (PH_EN(100)) {
            pg8::StaticOrder S; S.init(g.M, g.N, G, bid);
            pg8::gemm_phase<true>(lds, g, S, E, tid); }
        } else {
            switch (ph) {
                case 0: if (PH_EN(0)) prologue(a, lds, wave, lane, G, bid); break;
                case 2: if (PH_EN(2)) conv_phase((const bf16*)(ws + OFF_RAW), a.in[6], (bf16*)(ws + OFF_Z), G, tid, bid); break;
                case 7: case 21: if (PH_EN(7)) prep_phase(a, lds, wave, lane, G, bid, ph == 7); break;
                case 9: if (PH_EN(9)) cmp_stage2(a, wave, lane, G, bid); break;
                case 10: if (PH_EN(10)) nsa_cmp(a, lds, wave, lane, G, bid, tid); break;
                case 11: if (PH_EN(11)) nsa_sweep<false>(a, lds, wave, lane, G, bid, tid); break;
                case 12: if (PH_EN(12)) nsa_sweep<true>(a, lds, wave, lane, G, bid, tid); break;
                case 16: if (PH_EN(14)) pool_phase((const bf16*)(ws + OFF_XB), (const float*)(ws + OFF_SSQ) + 4 * SSQ_STRIDE, a.in[1] + 2 * D, (bf16*)(ws + OFF_Z), (LAS float*)lds, G, tid, bid); break;
                case 22: if (PH_EN(20)) sb_core(a, wave, lane, G, bid); break;
                default: break;
            }
        }
        if (pi + 1 < ph_hi) {
            if (ph_hi > 4096) { __syncthreads(); cg::this_grid().sync(); }
            else xcd_barrier(xbar);
        }
    }
}

extern "C" void kernel_launch(void* const* d_in, const int* in_sizes, int n_in, void* d_out, int out_size, void* d_ws, size_t ws_size, hipStream_t stream) {
    static int grid = 0;
    if (grid == 0) {
        if (n_in != 21 || out_size != M * D || ws_size < WS_END) { fprintf(stderr, "kernel_launch: unexpected shapes (n_in %d out %d ws %zu need %zu)\n", n_in, out_size, ws_size, (size_t)WS_END); grid = -1; return; }
        int dev = 0, cus = 0, per_cu = 0;
        hipGetDevice(&dev);
        hipDeviceGetAttribute(&cus, hipDeviceAttributeMultiprocessorCount, dev);
        if (hipFuncSetAttribute((const void*)fwd_kernel, hipFuncAttributeMaxDynamicSharedMemorySize, LDS_BYTES) != hipSuccess) { fprintf(stderr, "kernel_launch: hipFuncSetAttribute failed\n"); grid = -1; return; }
        if (hipOccupancyMaxActiveBlocksPerMultiprocessor(&per_cu, (const void*)fwd_kernel, NTHREADS, LDS_BYTES) != hipSuccess || per_cu < 1) { fprintf(stderr, "kernel_launch: occupancy query says %d\n", per_cu); per_cu = 1; }
        (void)hipGetLastError();
        grid = cus * 1;
        fprintf(stderr, "kernel_launch: cus %d per_cu %d grid %d\n", cus, per_cu, grid);
    }
    if (grid < 0) return;
    Args a{};
    for (int i = 0; i < 21; ++i) a.in[i] = (const float*)d_in[i];
    a.out = (float*)d_out; a.ws = (unsigned char*)d_ws;
    (void)hipMemsetAsync((char*)d_ws + OFF_CTL, 0, 65536, stream);
#if MK_MULTI
    for (int ph = 0; ph < NPH; ++ph) { a.ph_lo = ph; a.ph_hi = ph + 1; hipLaunchKernelGGL(fwd_kernel, dim3(grid), dim3(NTHREADS), LDS_BYTES, stream, a); }
#else
    a.ph_lo = 0; a.ph_hi = NPH + __builtin_popcountll(DUPMASK);
    void* args[] = {&a};
    hipError_t e = hipLaunchCooperativeKernel((const void*)fwd_kernel, dim3(grid), dim3(NTHREADS), args, LDS_BYTES, stream);
    if (e != hipSuccess) fprintf(stderr, "cooperative launch failed: %s (grid %d)\n", hipGetErrorString(e), grid);
#endif
}
```
